# Optimizing an MI355X kernel written in HIP

```python
import functools
import jax, jax.numpy as jnp
from jax import lax
import numpy as np

D_MODEL = 1024
BATCH = 2
SEQ = 8192
DEPTH = 1
DEC_BATCH = 8
DEC_SEQ = 64
PAST_LEN = 2048

CHUNK = 64
Q_BLOCK = 128
RET_HEADS = 4
RET_DK = 128
RET_DV = 256
MLA_HEADS = 8
Q_LORA = 512
KV_LORA = 256
NOPE_DIM = 128
ROPE_DIM = 64
V_DIM = 128
D_FF = ((8 * D_MODEL // 3 + 255) // 256) * 256
ROPE_BASE = 10000.0
EPS = 1e-6

RET_QK_W = RET_HEADS * RET_DK
RET_V_W = RET_HEADS * RET_DV
MLA_Q_W = MLA_HEADS * (NOPE_DIM + ROPE_DIM)
MLA_KV_W = MLA_HEADS * (NOPE_DIM + V_DIM)
MLA_V_W = MLA_HEADS * V_DIM
IN_W = 2 * RET_QK_W + 2 * RET_V_W + Q_LORA + KV_LORA + ROPE_DIM + 2 * D_MODEL

kernel_name = "retnet_mla_parallel_gated_stream_step"


def rms_norm(x, g):
    xf = x.astype(jnp.float32)
    y = xf * lax.rsqrt(jnp.mean(xf * xf, axis=-1, keepdims=True) + EPS)
    return (y * g.astype(jnp.float32)).astype(x.dtype)


def rope(x, pos):
    d = x.shape[-1]
    inv = ROPE_BASE ** (-jnp.arange(0, d, 2, dtype=jnp.float32) / d)
    ang = pos.astype(jnp.float32)[:, None] * inv[None, :]
    ang = ang.reshape(ang.shape[:1] + (1,) * (x.ndim - 3) + ang.shape[1:])
    cos, sin = jnp.cos(ang), jnp.sin(ang)
    xf = x.astype(jnp.float32)
    x1, x2 = xf[..., : d // 2], xf[..., d // 2:]
    return jnp.concatenate([x1 * cos - x2 * sin, x1 * sin + x2 * cos], axis=-1).astype(x.dtype)


def split_columns(z):
    sizes = (RET_QK_W, RET_QK_W, RET_V_W, RET_V_W, Q_LORA, KV_LORA, ROPE_DIM, D_MODEL, D_MODEL)
    offs = np.cumsum(sizes)[:-1].tolist()
    return jnp.split(z, offs, axis=-1)


def ret_log_gamma():
    return jnp.log(1.0 - 2.0 ** (-5.0 - jnp.arange(RET_HEADS, dtype=jnp.float32)))


def retention_chunk(state, q, k, v):
    L = q.shape[1]
    lg = ret_log_gamma()
    n = jnp.arange(L, dtype=jnp.float32)
    diff = n[:, None] - n[None, :]
    decay = jnp.where(diff >= 0, jnp.exp(lg[:, None, None] * jnp.maximum(diff, 0.0)), 0.0)
    scores = jnp.einsum('blhd,bmhd->bhlm', q, k) * decay
    inner = jnp.einsum('bhlm,bmhe->blhe', scores, v)
    q_decay = jnp.exp(lg[None, :] * (n[:, None] + 1.0))
    cross = jnp.einsum('blhd,bhde->blhe', q * q_decay[None, :, :, None], state)
    k_decay = jnp.exp(lg[None, :] * (L - 1.0 - n[:, None]))
    new_state = jnp.exp(lg * L)[None, :, None, None] * state + jnp.einsum('blhd,blhe->bhde', k * k_decay[None, :, :, None], v)
    return new_state, inner + cross


def retention_prompt(q, k, v):
    B, S, H, _ = q.shape
    nc = S // CHUNK
    def to_chunks(t):
        return t.astype(jnp.float32).reshape(B, nc, CHUNK, H, t.shape[-1]).swapaxes(0, 1)
    s0 = jnp.zeros((B, H, RET_DK, RET_DV), jnp.float32)
    s_fin, y = lax.scan(lambda s, c: retention_chunk(s, *c), s0, (to_chunks(q), to_chunks(k), to_chunks(v)))
    return y.swapaxes(0, 1).reshape(B, S, H, RET_DV), s_fin


def head_group_norm(y, g):
    mu = jnp.mean(y, axis=-1, keepdims=True)
    yc = y - mu
    yn = yc * lax.rsqrt(jnp.mean(yc * yc, axis=-1, keepdims=True) + EPS)
    B, S = y.shape[:2]
    return yn.reshape(B, S, RET_V_W) * g.astype(jnp.float32)


def mla_decompress(ckv, w_ukv):
    B, T, _ = ckv.shape
    kv = (ckv @ w_ukv).reshape(B, T, MLA_HEADS, NOPE_DIM + V_DIM)
    return kv[..., :NOPE_DIM], kv[..., NOPE_DIM:]


def mla_attend(q, k_nope, kpe, v, mask):
    scale = (NOPE_DIM + ROPE_DIM) ** -0.5
    s = (jnp.einsum('bqhd,bkhd->bhqk', q[..., :NOPE_DIM], k_nope).astype(jnp.float32)
         + jnp.einsum('bqhr,bkr->bhqk', q[..., NOPE_DIM:], kpe).astype(jnp.float32)) * scale
    s = jnp.where(mask, s, jnp.finfo(jnp.float32).min)
    p = jax.nn.softmax(s, axis=-1)
    return jnp.einsum('bhqk,bkhe->bqhe', p.astype(v.dtype), v)


def mla_prompt(q, ckv, kpe, w_ukv):
    B, S = q.shape[:2]
    k_nope, v = mla_decompress(ckv, w_ukv)
    nb = S // Q_BLOCK
    qb = q.reshape(B, nb, Q_BLOCK, MLA_HEADS, NOPE_DIM + ROPE_DIM).swapaxes(0, 1)
    key_chunk = jnp.arange(S) // CHUNK
    def one_block(args):
        qi, i = args
        q_chunk = (i * Q_BLOCK + jnp.arange(Q_BLOCK)) // CHUNK
        mask = key_chunk[None, :] <= q_chunk[:, None]
        return mla_attend(qi, k_nope, kpe, v, mask)
    out = lax.map(one_block, (qb, jnp.arange(nb)))
    return out.swapaxes(0, 1).reshape(B, S, MLA_V_W)


def prompt_core(rq, rk, rv, q, ckv, kpe, w_ukv):
    ret_y, s_fin = retention_prompt(rq, rk, rv)
    mla_y = mla_prompt(q, ckv, kpe, w_ukv)
    return ret_y, mla_y, (ckv, kpe, s_fin.astype(ckv.dtype))


def sample_core(cache_ckv, cache_kpe, state_ret, rq, rk, rv, q, ckv, kpe, w_ukv):
    f32 = jnp.float32
    B, L = q.shape[:2]
    s_new, ret_y = retention_chunk(state_ret.astype(f32), rq.astype(f32), rk.astype(f32), rv.astype(f32))
    keys_ckv = jnp.concatenate([cache_ckv.astype(ckv.dtype), ckv], axis=1)
    keys_kpe = jnp.concatenate([cache_kpe.astype(kpe.dtype), kpe], axis=1)
    k_nope, v = mla_decompress(keys_ckv, w_ukv)
    mask = jnp.ones((L, keys_ckv.shape[1]), dtype=bool)
    mla_y = mla_attend(q, k_nope, keys_kpe, v, mask).reshape(B, L, MLA_V_W)
    return ret_y, mla_y, (ckv, kpe, s_new.astype(state_ret.dtype))


def layer_forward(x, pos, mixer_core, norm_mix_w, w_in, q_norm_w, w_uq, kv_norm_w, w_ukv,
                  ret_gn_w, w_ret_o, w_mla_o, w_out, norm_ffn_w, w_gate_up, w_down):
    B, S, _ = x.shape
    xn = rms_norm(x, norm_mix_w)
    rq, rk, rv, rg, cq, ckv, kpe, ga, gb = split_columns(xn @ w_in)
    rq = rope(rq.reshape(B, S, RET_HEADS, RET_DK), pos)
    rk = rope(rk.reshape(B, S, RET_HEADS, RET_DK), pos) * (RET_DK ** -0.5)
    rv = rv.reshape(B, S, RET_HEADS, RET_DV)
    q = (rms_norm(cq, q_norm_w) @ w_uq).reshape(B, S, MLA_HEADS, NOPE_DIM + ROPE_DIM)
    q = jnp.concatenate([q[..., :NOPE_DIM], rope(q[..., NOPE_DIM:], pos)], axis=-1)
    ckv = rms_norm(ckv, kv_norm_w)
    kpe = rope(kpe, pos)
    ret_y, mla_y, new_state = mixer_core(rq, rk, rv, q, ckv, kpe, w_ukv)
    ret_branch = (head_group_norm(ret_y, ret_gn_w).astype(x.dtype) * jax.nn.silu(rg)) @ w_ret_o
    mla_branch = mla_y @ w_mla_o
    merged = jax.nn.sigmoid(ga) * ret_branch + jax.nn.sigmoid(gb) * mla_branch
    h = x + merged @ w_out
    g, u = jnp.split(rms_norm(h, norm_ffn_w) @ w_gate_up, 2, axis=-1)
    h = h + (jax.nn.silu(g) * u) @ w_down
    return h, new_state


def setup_inputs(seed: int = 0) -> dict:
    key = jax.random.key(seed)
    ks = jax.random.split(key, 24)
    f32 = jnp.float32
    def w(k, shape, fan_in):
        return jax.random.normal(k, shape, f32) * fan_in ** -0.5
    def gain(k, shape):
        return 1.0 + 0.02 * jax.random.normal(k, shape, f32)
    return {
        "x_prompt": jax.random.normal(ks[0], (BATCH, SEQ, D_MODEL), f32),
        "x_sample": jax.random.normal(ks[1], (DEC_BATCH, DEC_SEQ, D_MODEL), f32),
        "cache_ckv": jax.random.normal(ks[2], (DEPTH, DEC_BATCH, PAST_LEN, KV_LORA), f32),
        "cache_kpe": jax.random.normal(ks[3], (DEPTH, DEC_BATCH, PAST_LEN, ROPE_DIM), f32),
        "state_ret": 0.5 * jax.random.normal(ks[4], (DEPTH, DEC_BATCH, RET_HEADS, RET_DK, RET_DV), f32),
        "norm_mix_w": gain(ks[5], (DEPTH, D_MODEL)),
        "w_in": w(ks[6], (DEPTH, D_MODEL, IN_W), D_MODEL),
        "q_norm_w": gain(ks[7], (DEPTH, Q_LORA)),
        "w_uq": w(ks[8], (DEPTH, Q_LORA, MLA_Q_W), Q_LORA),
        "kv_norm_w": gain(ks[9], (DEPTH, KV_LORA)),
        "w_ukv": w(ks[10], (DEPTH, KV_LORA, MLA_KV_W), KV_LORA),
        "ret_gn_w": gain(ks[11], (DEPTH, RET_V_W)),
        "w_ret_o": w(ks[12], (DEPTH, RET_V_W, D_MODEL), RET_V_W),
        "w_mla_o": w(ks[13], (DEPTH, MLA_V_W, D_MODEL), MLA_V_W),
        "w_out": w(ks[14], (DEPTH, D_MODEL, D_MODEL), D_MODEL),
        "norm_ffn_w": gain(ks[15], (DEPTH, D_MODEL)),
        "w_gate_up": w(ks[16], (DEPTH, D_MODEL, 2 * D_FF), D_MODEL),
        "w_down": w(ks[17], (DEPTH, D_FF, D_MODEL), D_FF),
        "norm_final_w": gain(ks[18], (D_MODEL,)),
    }


def reference(x_prompt, x_sample, cache_ckv, cache_kpe, state_ret, norm_mix_w, w_in, q_norm_w, w_uq,
              kv_norm_w, w_ukv, ret_gn_w, w_ret_o, w_mla_o, w_out, norm_ffn_w, w_gate_up, w_down, norm_final_w):
    past = cache_ckv.shape[2]
    pos_p = jnp.arange(x_prompt.shape[1])
    pos_s = past + jnp.arange(x_sample.shape[1])
    hp, hs = x_prompt, x_sample
    p_ckv, p_kpe, p_ret, s_ckv, s_kpe, s_ret = [], [], [], [], [], []
    for l in range(DEPTH):
        lw = (norm_mix_w[l], w_in[l], q_norm_w[l], w_uq[l], kv_norm_w[l], w_ukv[l], ret_gn_w[l],
              w_ret_o[l], w_mla_o[l], w_out[l], norm_ffn_w[l], w_gate_up[l], w_down[l])
        hp, (a, b, c) = layer_forward(hp, pos_p, prompt_core, *lw)
        core = functools.partial(sample_core, cache_ckv[l], cache_kpe[l], state_ret[l])
        hs, (d, e, f) = layer_forward(hs, pos_s, core, *lw)
        p_ckv.append(a); p_kpe.append(b); p_ret.append(c)
        s_ckv.append(d); s_kpe.append(e); s_ret.append(f)
    y_prompt = rms_norm(hp, norm_final_w)
    y_sample = rms_norm(hs, norm_final_w)
    return (y_prompt, y_sample, jnp.stack(p_ckv), jnp.stack(p_kpe), jnp.stack(p_ret),
            jnp.stack(s_ckv), jnp.stack(s_kpe), jnp.stack(s_ret))
```

```cpp
#include <hip/hip_runtime.h>
#include <hip/hip_cooperative_groups.h>
#include <cstdio>
#include <cstdint>
namespace cg = cooperative_groups;

typedef unsigned short bf16_t;
typedef short bf16x8 __attribute__((ext_vector_type(8)));
typedef float f32x4 __attribute__((ext_vector_type(4)));
typedef float f32x2 __attribute__((ext_vector_type(2)));
typedef float f32x16 __attribute__((ext_vector_type(16)));
typedef unsigned u32x4 __attribute__((ext_vector_type(4)));
typedef unsigned u32x2 __attribute__((ext_vector_type(2)));
typedef __bf16 bf16v2 __attribute__((ext_vector_type(2)));
#define DI __device__ __forceinline__

#ifndef LAST_PHASE
#define LAST_PHASE 99
#endif

constexpr int TP = 16384, TS = 512, TALL = 16896;
constexpr int NKV = 33280;
constexpr int NTHREADS = 512;

constexpr size_t SZ_WIN = 6144ull * 1024 * 2, SZ_WUQ = 1536ull * 512 * 2, SZ_WUKV = 2048ull * 256 * 2, SZ_W1K = 1024ull * 1024 * 2,
                 SZ_WGU = 5632ull * 1024 * 2, SZ_WDN = 1024ull * 2816 * 2;
constexpr size_t OFF_WIN = 0, OFF_WUQ = OFF_WIN + SZ_WIN, OFF_WUKV = OFF_WUQ + SZ_WUQ, OFF_WRO = OFF_WUKV + SZ_WUKV, OFF_WMO = OFF_WRO + SZ_W1K,
                 OFF_WOUT = OFF_WMO + SZ_W1K, OFF_WGU = OFF_WOUT + SZ_W1K, OFF_WDN = OFF_WGU + SZ_WGU;
constexpr size_t SZ_T1K = (size_t)TALL * 1024 * 2, SZ_T512 = (size_t)TALL * 512 * 2;
constexpr size_t OFF_XN = OFF_WDN + SZ_WDN;
constexpr size_t OFF_CKVALL = OFF_XN + SZ_T1K, SZ_CKVALL = (size_t)NKV * 256 * 2;
constexpr size_t OFF_KPEALL = OFF_CKVALL + SZ_CKVALL, SZ_KPEALL = (size_t)NKV * 64 * 2;
constexpr size_t OFF_POOL = OFF_KPEALL + SZ_KPEALL;
constexpr size_t OFF_CQ = OFF_POOL;
constexpr size_t OFF_RETIN = OFF_CQ + SZ_T512;
constexpr size_t OFF_CKVRAW = OFF_RETIN, OFF_KPERAW = OFF_CKVRAW + (size_t)TALL * 256 * 2;
constexpr size_t OFF_BIG = OFF_RETIN + SZ_T1K;
constexpr size_t OFF_RQ = OFF_BIG, OFF_RK = OFF_RQ + SZ_T512, OFF_RKT = OFF_RK + SZ_T512, OFF_RVT = OFF_RKT + SZ_T512, OFF_SRG = OFF_RVT + SZ_T1K;
constexpr size_t SZ_Q = (size_t)TALL * 1536 * 2, SZ_KNS = 8ull * 8 * 2112 * 128 * 2;
constexpr size_t OFF_Q = OFF_BIG, OFF_KNS = OFF_Q + SZ_Q, OFF_VTS = OFF_KNS + SZ_KNS;
constexpr size_t OFF_SGA = OFF_KNS, OFF_SGB = OFF_VTS;
constexpr size_t OFF_MERGED = OFF_XN, OFF_HN = OFF_CQ, OFF_ACT = OFF_BIG;
constexpr size_t OFF_CTR = OFF_BIG + 3 * SZ_T512 + 2 * SZ_T1K;
static_assert(OFF_VTS + SZ_KNS == OFF_CTR, "mla overlay must match retention overlay");
static_assert(OFF_CTR + 4096 <= 268435456ull, "workspace overflow");
constexpr size_t RKT_S = 2ull * 4 * 128 * 8192, RVT_S = 2ull * 4 * 256 * 8192;
constexpr size_t O_YP = 0, O_YS = 16777216, O_CKVP = 17301504, O_KPEP = 21495808, O_STP = 22544384, O_CKVS = 22806528, O_KPES = 22937600, O_STS = 22970368;
constexpr size_t SZ_KNP = 2ull * 8 * 8192 * 128 * 2;

__device__ const double THETA_REV[64] = {
0.15915494309189535, 0.13782250260398285, 0.11934937021124886, 0.10335229661843406, 0.08949940160889101, 0.07750328875537406, 0.06711508300522726, 0.058119267441876246, 0.050329212104487035, 0.04358330210530733, 0.03774158471741977, 0.032682865872357, 0.0283021958306234, 0.024508691862069852, 0.02122365276477766, 0.018378926105679667, 0.015915494309189534, 0.013782250260398284, 0.011934937021124886, 0.010335229661843406, 0.008949940160889102, 0.0077503288755374055, 0.006711508300522725, 0.005811926744187624, 0.005032921210448704, 0.004358330210530733, 0.003774158471741977, 0.0032682865872356993, 0.00283021958306234, 0.002450869186206985, 0.0021223652764777662, 0.0018378926105679667, 0.0015915494309189536, 0.0013782250260398288, 0.0011934937021124885, 0.0010335229661843405, 0.0008949940160889102, 0.0007750328875537405, 0.0006711508300522726, 0.0005811926744187624, 0.0005032921210448703, 0.0004358330210530733, 0.00037741584717419774, 0.0003268286587235699, 0.00028302195830623395, 0.00024508691862069854, 0.0002122365276477766, 0.00018378926105679666, 0.00015915494309189535, 0.00013782250260398286, 0.00011934937021124886, 0.00010335229661843406, 8.949940160889102e-05, 7.750328875537406e-05, 6.711508300522725e-05, 5.811926744187624e-05, 5.0329212104487035e-05, 4.358330210530732e-05, 3.774158471741978e-05, 3.2682865872357e-05, 2.8302195830623396e-05, 2.4508691862069852e-05, 2.122365276477766e-05, 1.8378926105679668e-05};

struct Params {
    const float *x_p, *x_s, *c_ckv, *c_kpe, *st, *nmix, *w_in, *qn, *w_uq, *kvn, *w_ukv, *gn, *w_ro, *w_mo, *w_out, *nffn, *w_gu, *w_dn, *nfin;
    float* out;
    char* ws;
};

DI float bf2f(bf16_t h) { return __uint_as_float((unsigned)h << 16); }
DI unsigned pk2(float lo, float hi) {
    f32x2 v = {lo, hi};
    bf16v2 b = __builtin_convertvector(v, bf16v2);
    return __builtin_bit_cast(unsigned, b);
}
DI bf16_t f2bf(float x) { return (bf16_t)(pk2(x, 0.f) & 0xffffu); }
DI u32x2 pk4(f32x4 v) { u32x2 r; r.x = pk2(v[0], v[1]); r.y = pk2(v[2], v[3]); return r; }
DI float fexp2(float x) { return __builtin_amdgcn_exp2f(x); }
DI float frcp(float x) { return __builtin_amdgcn_rcpf(x); }
DI float sigmoidf_(float x) { return frcp(1.0f + fexp2(-1.44269504089f * x)); }
DI float siluf_(float x) { return x * sigmoidf_(x); }
DI float wave_sum(float v) {
#pragma unroll
    for (int o = 32; o >= 1; o >>= 1) v += __shfl_xor(v, o);
    return v;
}
DI void rope_cs(int pos, int i, float& c, float& s) {
    double r = (double)pos * THETA_REV[i];
    r = r - __builtin_floor(r);
    const float rf = (float)r;
    s = __builtin_amdgcn_sinf(rf);
    c = __builtin_amdgcn_cosf(rf);
}
DI float lg2gamma(int h) { return h == 0 ? -0.04580368961312479f : h == 1 ? -0.02272007650008353f : h == 2 ? -0.011315313227834146f : -0.005646563141142063f; }
struct RowInfo { int isS, b, t, pos; };
DI RowInfo rinfo(int row) {
    RowInfo r;
    if (row < TP) { r.isS = 0; r.b = row >> 13; r.t = row & 8191; r.pos = r.t; }
    else { const int q = row - TP; r.isS = 1; r.b = q >> 6; r.t = q & 63; r.pos = 2048 + r.t; }
    return r;
}
DI int kvrow(const RowInfo& ri, int row) { return ri.isS ? (TP + ri.b * 2112 + 2048 + ri.t) : row; }

constexpr int BM = 256, BK = 64, HALF = 128, HT = HALF * BK;
DI int lds_byte(int r, int c) {
    int st = (r >> 4) * 2 + (c >> 5), rr = r & 15, cc = c & 31, ob = rr * 64 + cc * 2;
    return st * 1024 + (ob ^ (((ob >> 9) & 1) << 5));
}
DI void stage_rc(int b, int& R, int& C) {
    int st = b / 1024, sb = b % 1024, swz = sb ^ (((sb >> 9) & 1) << 5);
    R = (st >> 1) * 16 + swz / 64; C = (st & 1) * 32 + (swz % 64) / 2;
}
DI bool tile_order(int L, int nM, int nN, int& pm, int& pn) {
    const int nwg = nM * nN;
    if (L >= nwg) return false;
    int wgid = L;
    { const int q = nwg / 8, r = nwg % 8, xcd = wgid % 8, off = wgid / 8; wgid = (xcd < r ? xcd * (q + 1) : r * (q + 1) + (xcd - r) * q) + off; }
    const int nig = 8 * nN, gid = wgid / nig, fm = gid * 8, gsz = (nM - fm) < 8 ? (nM - fm) : 8;
    pm = fm + ((wgid % nig) % gsz); pn = (wgid % nig) / gsz;
    return true;
}

#define LAS __attribute__((address_space(3)))
DI void gemm_kloop(f32x4 (&acc)[2][2][4][2], const bf16_t* __restrict__ A, int lda, bool a192, const bf16_t* __restrict__ Bt, int ldb, int nt,
                   int brow, int bcol, LAS unsigned char* lds) {
    int tid = threadIdx.x; asm volatile("" : "+v"(tid));
    const int wid = __builtin_amdgcn_readfirstlane(tid >> 6), lane = tid & 63, wr = wid >> 2, wc = wid & 3, fr = lane & 15, fq = lane >> 4;
    unsigned voffA[2], voffB[2];
#pragma unroll
    for (int i = 0; i < 2; ++i) { int R, C; stage_rc(tid * 16 + i * 8192, R, C); voffA[i] = (unsigned)(R * lda + C) * 2u; voffB[i] = (unsigned)(R * ldb + C) * 2u; }
    const size_t hstepA = (size_t)HALF * lda * 2, hstepB = (size_t)HALF * ldb * 2;
    const unsigned ldsw = (unsigned)wid * 1024u;
    const int aoff = lds_byte(wr * 64 + fr, fq * 8), boff = lds_byte(wc * 32 + fr, fq * 8);
    const char* cA = (const char*)A + (size_t)brow * lda * 2;
    const char* cB = (const char*)Bt + (size_t)bcol * ldb * 2;
    constexpr int HTB = HALF * BK * 2;
#define SA(b, h) (((b) * 2 + (h)) * HTB)
#define SB(b, h) ((4 + (b) * 2 + (h)) * HTB)
#define AKO(kt) ((size_t)(a192 ? (((kt) >> 1) * 192 + ((kt) & 1) * 64) : (kt) * 64) * 2)
#define STAGE_(bufoff, gbase, voff) do { _Pragma("unroll") for (int _i = 0; _i < 2; ++_i) \
      __builtin_amdgcn_global_load_lds((const unsigned*)((const char*)(gbase) + (voff)[_i]), (LAS unsigned*)(lds + (bufoff) + ldsw + _i * 8192), 16, 0, 0); } while (0)
#define STAGEA(buf, h, kt) STAGE_(buf, cA + (h) * hstepA + AKO(kt), voffA)
#define STAGEB(buf, h, kt) STAGE_(buf, cB + (h) * hstepB + (size_t)(kt) * 128, voffB)
#define LDA(dst, b, h) do { _Pragma("unroll") for (int m = 0; m < 4; ++m) _Pragma("unroll") for (int k = 0; k < 2; ++k) dst[m][k] = *(const LAS bf16x8*)(lds + SA(b, h) + aoff + m * 2048 + k * 1024); } while (0)
#define LDB(dst, b, h) do { _Pragma("unroll") for (int n = 0; n < 2; ++n) _Pragma("unroll") for (int k = 0; k < 2; ++k) dst[n][k] = *(const LAS bf16x8*)(lds + SB(b, h) + boff + n * 2048 + k * 1024); } while (0)
#define MMA(ai, bj, At_, Bt_) do { __builtin_amdgcn_s_setprio(1); _Pragma("unroll") for (int m = 0; m < 4; ++m) _Pragma("unroll") for (int n = 0; n < 2; ++n) _Pragma("unroll") for (int k = 0; k < 2; ++k) \
      acc[ai][bj][m][n] = __builtin_amdgcn_mfma_f32_16x16x32_bf16(Bt_[n][k], At_[m][k], acc[ai][bj][m][n], 0, 0, 0); \
    __builtin_amdgcn_s_setprio(0); } while (0)
#define WAIT_V(n) asm volatile("s_waitcnt vmcnt(" #n ")" ::: "memory")
#define WAIT_L(n) asm volatile("s_waitcnt lgkmcnt(" #n ")" ::: "memory")
#define BAR __builtin_amdgcn_s_barrier()
#define SCHED __builtin_amdgcn_sched_barrier(0)
    bf16x8 At[4][2], B0[2][2], B1[2][2];
    WAIT_V(0);
    STAGEB(SB(0, 0), 0, 0); STAGEA(SA(0, 0), 0, 0);
    STAGEB(SB(0, 1), 1, 0); STAGEA(SA(0, 1), 1, 0);
    if (wr == 1) BAR;
    WAIT_V(4); BAR;
    STAGEB(SB(1, 0), 0, 1); STAGEA(SA(1, 0), 0, 1); STAGEB(SB(1, 1), 1, 1);
    WAIT_V(6); BAR;
    for (int t = 0; t < nt - 2; t += 2) {
        LDB(B0, 0, 0); SCHED; LDA(At, 0, 0); STAGEA(SA(1, 1), 1, t + 1);
        WAIT_L(8); BAR; WAIT_L(0); MMA(0, 0, At, B0); BAR; SCHED;
        LDB(B1, 0, 1); STAGEB(SB(0, 0), 0, t + 2);
        BAR; WAIT_L(0); MMA(0, 1, At, B1); BAR;
        LDA(At, 0, 1); STAGEA(SA(0, 0), 0, t + 2);
        BAR; WAIT_L(0); MMA(1, 0, At, B0); BAR; SCHED;
        STAGEB(SB(0, 1), 1, t + 2);
        WAIT_V(6); BAR; MMA(1, 1, At, B1); BAR;
        LDB(B0, 1, 0); SCHED; LDA(At, 1, 0); STAGEA(SA(0, 1), 1, t + 2);
        WAIT_L(8); BAR; WAIT_L(0); MMA(0, 0, At, B0); BAR; SCHED;
        LDB(B1, 1, 1); STAGEB(SB(1, 0), 0, t + 3);
        BAR; WAIT_L(0); MMA(0, 1, At, B1); BAR;
        LDA(At, 1, 1); STAGEA(SA(1, 0), 0, t + 3);
        BAR; WAIT_L(0); MMA(1, 0, At, B0); BAR; SCHED;
        STAGEB(SB(1, 1), 1, t + 3);
        WAIT_V(6); BAR; MMA(1, 1, At, B1); BAR;
    }
    { LDB(B0, 0, 0); LDA(At, 0, 0); STAGEA(SA(1, 1), 1, nt - 1);
      BAR; WAIT_L(0); MMA(0, 0, At, B0); BAR;
      LDB(B1, 0, 1); BAR; WAIT_L(0); MMA(0, 1, At, B1); BAR;
      LDA(At, 0, 1); WAIT_V(4); BAR; WAIT_L(0); MMA(1, 0, At, B0); MMA(1, 1, At, B1); BAR; }
    { LDB(B0, 1, 0); LDA(At, 1, 0); WAIT_V(2); BAR; WAIT_L(0); MMA(0, 0, At, B0); BAR;
      LDB(B1, 1, 1); WAIT_V(0); BAR; WAIT_L(0); MMA(0, 1, At, B1); BAR;
      LDA(At, 1, 1); BAR; WAIT_L(0); MMA(1, 0, At, B0); MMA(1, 1, At, B1); BAR; }
    if (wr == 0) BAR;
}
#define ZERO_ACC(acc) for (int a_ = 0; a_ < 2; ++a_) for (int b_ = 0; b_ < 2; ++b_) for (int m_ = 0; m_ < 4; ++m_) for (int n_ = 0; n_ < 2; ++n_) acc[a_][b_][m_][n_] = (f32x4){0.f, 0.f, 0.f, 0.f}
#define EPI_IDS int lane = threadIdx.x & 63, wid = __builtin_amdgcn_readfirstlane(threadIdx.x >> 6); asm volatile("" : "+v"(lane), "+s"(wid)); const int wr = wid >> 2, wc = wid & 3, fr = lane & 15, fq = lane >> 4

template <class F>
DI void conv_w(const float* __restrict__ W, int K, int Norig, bf16_t* __restrict__ Wt, int Nt, F perm, int gtid, int nth) {
    const int total = (K / 8) * Nt;
    for (int idx = gtid; idx < total; idx += nth) {
        const int n = idx % Nt, k8 = idx / Nt;
        const int col = perm(n);
        float v[8];
#pragma unroll
        for (int j = 0; j < 8; ++j) v[j] = col >= 0 ? W[(size_t)(k8 * 8 + j) * Norig + col] : 0.f;
        u32x4 o; o.x = pk2(v[0], v[1]); o.y = pk2(v[2], v[3]); o.z = pk2(v[4], v[5]); o.w = pk2(v[6], v[7]);
        *(u32x4*)(Wt + (size_t)n * K + k8 * 8) = o;
    }
}
DI int perm_win(int n) {
    const int tc = n >> 8, c = n & 255;
    if (tc < 4) { const int half = c >> 7, e = (c >> 6) & 1, i = c & 63; return (tc >> 1) * 512 + (2 * (tc & 1) + e) * 128 + half * 64 + i; }
    if (tc < 15) return n;
    if (tc == 15) return c < 64 ? 3840 + c : -1;
    return 3904 + (n - 4096);
}
DI int perm_wuq(int n) {
    const int tc = n >> 8, c = n & 255;
    if (tc < 4) { const int e = c >> 7, d = c & 127; return (2 * tc + e) * 192 + d; }
    const int half = c >> 7, e = (c >> 5) & 3, i = c & 31;
    return (4 * (tc - 4) + e) * 192 + 128 + half * 32 + i;
}
DI int perm_wukv(int n) {
    const int tc = n >> 8, c = n & 255;
    const int e = c >> 7, d = c & 127;
    if (tc < 4) return (2 * tc + e) * 256 + d;
    return (2 * (tc - 4) + e) * 256 + 128 + d;
}
DI int perm_wgu(int n) { const int tc = n >> 8, c = n & 255; return (c >> 7) * 2816 + tc * 128 + (c & 127); }
DI int perm_id(int n) { return n; }

DI void rmsnorm_row_1024(const float* __restrict__ x, const float* __restrict__ g, bf16_t* __restrict__ o, int lane) {
    f32x4 v[4]; float ss = 0.f;
#pragma unroll
    for (int i = 0; i < 4; ++i) { v[i] = *(const f32x4*)(x + i * 256 + lane * 4); ss += v[i][0] * v[i][0] + v[i][1] * v[i][1] + v[i][2] * v[i][2] + v[i][3] * v[i][3]; }
    ss = wave_sum(ss);
    const float rstd = rsqrtf(ss * (1.0f / 1024.0f) + 1e-6f);
#pragma unroll
    for (int i = 0; i < 4; ++i) { const f32x4 gg = *(const f32x4*)(g + i * 256 + lane * 4); *(u32x2*)(o + i * 256 + lane * 4) = pk4(v[i] * rstd * gg); }
}

DI void phase0(const Params& p) {
    const int gtid = blockIdx.x * NTHREADS + threadIdx.x, nth = gridDim.x * NTHREADS;
    char* ws = p.ws;
    if (gtid < 64) ((unsigned*)(ws + OFF_CTR))[gtid] = 0u;
    conv_w(p.w_in, 1024, 5952, (bf16_t*)(ws + OFF_WIN), 6144, perm_win, gtid, nth);
    conv_w(p.w_uq, 512, 1536, (bf16_t*)(ws + OFF_WUQ), 1536, perm_wuq, gtid, nth);
    conv_w(p.w_ukv, 256, 2048, (bf16_t*)(ws + OFF_WUKV), 2048, perm_wukv, gtid, nth);
    conv_w(p.w_ro, 1024, 1024, (bf16_t*)(ws + OFF_WRO), 1024, perm_id, gtid, nth);
    conv_w(p.w_mo, 1024, 1024, (bf16_t*)(ws + OFF_WMO), 1024, perm_id, gtid, nth);
    conv_w(p.w_out, 1024, 1024, (bf16_t*)(ws + OFF_WOUT), 1024, perm_id, gtid, nth);
    conv_w(p.w_gu, 1024, 5632, (bf16_t*)(ws + OFF_WGU), 5632, perm_wgu, gtid, nth);
    conv_w(p.w_dn, 2816, 1024, (bf16_t*)(ws + OFF_WDN), 1024, perm_id, gtid, nth);
    const int gw = gtid >> 6, nw = nth >> 6, lane = threadIdx.x & 63;
    bf16_t* xn = (bf16_t*)(ws + OFF_XN);
    for (int row = gw; row < TALL; row += nw) {
        const float* x = row < TP ? p.x_p + (size_t)row * 1024 : p.x_s + (size_t)(row - TP) * 1024;
        rmsnorm_row_1024(x, p.nmix, xn + (size_t)row * 1024, lane);
    }
    bf16_t* ckvall = (bf16_t*)(ws + OFF_CKVALL); bf16_t* kpeall = (bf16_t*)(ws + OFF_KPEALL);
    for (int idx = gtid; idx < 8 * 2048 * 64; idx += nth) {
        const int c4 = idx & 63, r = idx >> 6, b = r >> 11, j = r & 2047;
        const f32x4 v = *(const f32x4*)(p.c_ckv + (size_t)r * 256 + c4 * 4);
        *(u32x2*)(ckvall + (size_t)(TP + b * 2112 + j) * 256 + c4 * 4) = pk4(v);
    }
    for (int idx = gtid; idx < 8 * 2048 * 16; idx += nth) {
        const int c4 = idx & 15, r = idx >> 4, b = r >> 11, j = r & 2047;
        const f32x4 v = *(const f32x4*)(p.c_kpe + (size_t)r * 64 + c4 * 4);
        *(u32x2*)(kpeall + (size_t)(TP + b * 2112 + j) * 64 + c4 * 4) = pk4(v);
    }
}

DI void epi_win(const Params& p, const f32x4 (&acc)[2][2][4][2], int pm, int tc) {
    EPI_IDS;
    char* ws = p.ws;
    const int row0 = pm * 256 + wr * 64 + fr;
    if (tc < 4) {
        const bool isK = tc >= 2;
        bf16_t* nat = (bf16_t*)(ws + (isK ? OFF_RK : OFF_RQ));
        bf16_t* rkt = (bf16_t*)(ws + OFF_RKT);
        const float sc = isK ? 0.08838834764831845f : 1.0f;
#pragma unroll
        for (int ai = 0; ai < 2; ++ai)
#pragma unroll
            for (int m = 0; m < 4; ++m) {
                const int row = row0 + ai * 128 + m * 16;
                const RowInfo ri = rinfo(row);
#pragma unroll
                for (int n = 0; n < 2; ++n) {
                    const int cw = wc * 32 + n * 16 + fq * 4, e = cw >> 6, i0 = cw & 63, head = 2 * (tc & 1) + e;
                    const f32x4 x1 = acc[ai][0][m][n], x2 = acc[ai][1][m][n];
                    f32x4 o1, o2;
#pragma unroll
                    for (int j = 0; j < 4; ++j) { float c, s; rope_cs(ri.pos, i0 + j, c, s); o1[j] = (x1[j] * c - x2[j] * s) * sc; o2[j] = (x1[j] * s + x2[j] * c) * sc; }
                    *(u32x2*)(nat + (size_t)row * 512 + head * 128 + i0) = pk4(o1);
                    *(u32x2*)(nat + (size_t)row * 512 + head * 128 + 64 + i0) = pk4(o2);
                    if (isK) {
                        const float dec = fexp2((float)(63 - (ri.t & 63)) * lg2gamma(head));
                        bf16_t* base; size_t ts;
                        if (!ri.isS) { base = rkt + ((size_t)(ri.b * 4 + head) * 128) * 8192 + ri.t; ts = 8192; }
                        else { base = rkt + RKT_S + ((size_t)(ri.b * 4 + head) * 128) * 64 + ri.t; ts = 64; }
#pragma unroll
                        for (int j = 0; j < 4; ++j) { base[(size_t)(i0 + j) * ts] = f2bf(o1[j] * dec); base[(size_t)(64 + i0 + j) * ts] = f2bf(o2[j] * dec); }
                    }
                }
            }
    } else if (tc < 8) {
        bf16_t* rvt = (bf16_t*)(ws + OFF_RVT);
        const int head = tc - 4;
#pragma unroll
        for (int ai = 0; ai < 2; ++ai)
#pragma unroll
            for (int m = 0; m < 4; ++m) {
                const int row = row0 + ai * 128 + m * 16;
                const RowInfo ri = rinfo(row);
                bf16_t* base; size_t ts;
                if (!ri.isS) { base = rvt + ((size_t)(ri.b * 4 + head) * 256) * 8192 + ri.t; ts = 8192; }
                else { base = rvt + RVT_S + ((size_t)(ri.b * 4 + head) * 256) * 64 + ri.t; ts = 64; }
#pragma unroll
                for (int bj = 0; bj < 2; ++bj)
#pragma unroll
                    for (int n = 0; n < 2; ++n) {
                        const int d0 = bj * 128 + wc * 32 + n * 16 + fq * 4;
#pragma unroll
                        for (int j = 0; j < 4; ++j) base[(size_t)(d0 + j) * ts] = f2bf(acc[ai][bj][m][n][j]);
                    }
            }
    } else {
        bf16_t* dst; int ld, cbase, act = 0;
        if (tc < 12) { dst = (bf16_t*)(ws + OFF_SRG); ld = 1024; cbase = (tc - 8) * 256; act = 1; }
        else if (tc < 14) { dst = (bf16_t*)(ws + OFF_CQ); ld = 512; cbase = (tc - 12) * 256; }
        else if (tc == 14) { dst = (bf16_t*)(ws + OFF_CKVRAW); ld = 256; cbase = 0; }
        else if (tc == 15) { dst = (bf16_t*)(ws + OFF_KPERAW); ld = 64; cbase = 0; }
        else if (tc < 20) { dst = (bf16_t*)(ws + OFF_SGA); ld = 1024; cbase = (tc - 16) * 256; act = 2; }
        else { dst = (bf16_t*)(ws + OFF_SGB); ld = 1024; cbase = (tc - 20) * 256; act = 2; }
#pragma unroll
        for (int ai = 0; ai < 2; ++ai)
#pragma unroll
            for (int m = 0; m < 4; ++m) {
                const int row = row0 + ai * 128 + m * 16;
#pragma unroll
                for (int bj = 0; bj < 2; ++bj)
#pragma unroll
                    for (int n = 0; n < 2; ++n) {
                        const int c = bj * 128 + wc * 32 + n * 16 + fq * 4;
                        if (tc == 15 && c >= 64) continue;
                        f32x4 v = acc[ai][bj][m][n];
                        if (act == 1) { for (int j = 0; j < 4; ++j) v[j] = siluf_(v[j]); }
                        else if (act == 2) { for (int j = 0; j < 4; ++j) v[j] = sigmoidf_(v[j]); }
                        *(u32x2*)(dst + (size_t)row * ld + cbase + c) = pk4(v);
                    }
            }
    }
}
DI void phase_gemm_in(const Params& p, int tc0, int ntc, LAS unsigned char* shm) {
    const bf16_t* A = (const bf16_t*)(p.ws + OFF_XN);
    const bf16_t* Bt = (const bf16_t*)(p.ws + OFF_WIN);
    for (int L = blockIdx.x;; L += gridDim.x) {
        int pm, pn; if (!tile_order(L, TALL / 256, ntc, pm, pn)) break;
        f32x4 acc[2][2][4][2]; ZERO_ACC(acc);
        gemm_kloop(acc, A, 1024, false, Bt, 1024, 16, pm * 256, (tc0 + pn) * 256, shm);
        epi_win(p, acc, pm, tc0 + pn);
    }
}

DI void phase2_elem(const Params& p) {
    const int gtid = blockIdx.x * NTHREADS + threadIdx.x, nth = gridDim.x * NTHREADS;
    const int gw = gtid >> 6, nw = nth >> 6, lane = threadIdx.x & 63;
    char* ws = p.ws;
    bf16_t* cq = (bf16_t*)(ws + OFF_CQ);
    const bf16_t* ckvraw = (const bf16_t*)(ws + OFF_CKVRAW);
    const bf16_t* kperaw = (const bf16_t*)(ws + OFF_KPERAW);
    bf16_t* ckvall = (bf16_t*)(ws + OFF_CKVALL); bf16_t* kpeall = (bf16_t*)(ws + OFF_KPEALL);
    for (int row = gw; row < TALL; row += nw) {
        const RowInfo ri = rinfo(row);
        const int kr = kvrow(ri, row);
        {
            const u32x4 raw = *(const u32x4*)(cq + (size_t)row * 512 + lane * 8);
            float v[8];
#pragma unroll
            for (int j = 0; j < 4; ++j) { v[2 * j] = __uint_as_float(raw[j] << 16); v[2 * j + 1] = __uint_as_float(raw[j] & 0xffff0000u); }
            float ss = 0.f;
#pragma unroll
            for (int j = 0; j < 8; ++j) ss += v[j] * v[j];
            ss = wave_sum(ss);
            const float rstd = rsqrtf(ss * (1.0f / 512.0f) + 1e-6f);
            const f32x4 g0 = *(const f32x4*)(p.qn + lane * 8), g1 = *(const f32x4*)(p.qn + lane * 8 + 4);
            u32x4 o; o.x = pk2(v[0] * rstd * g0[0], v[1] * rstd * g0[1]); o.y = pk2(v[2] * rstd * g0[2], v[3] * rstd * g0[3]);
            o.z = pk2(v[4] * rstd * g1[0], v[5] * rstd * g1[1]); o.w = pk2(v[6] * rstd * g1[2], v[7] * rstd * g1[3]);
            *(u32x4*)(cq + (size_t)row * 512 + lane * 8) = o;
        }
        {
            const u32x2 raw = *(const u32x2*)(ckvraw + (size_t)row * 256 + lane * 4);
            f32x4 v; v[0] = __uint_as_float(raw.x << 16); v[1] = __uint_as_float(raw.x & 0xffff0000u); v[2] = __uint_as_float(raw.y << 16); v[3] = __uint_as_float(raw.y & 0xffff0000u);
            float ss = v[0] * v[0] + v[1] * v[1] + v[2] * v[2] + v[3] * v[3];
            ss = wave_sum(ss);
            const float rstd = rsqrtf(ss * (1.0f / 256.0f) + 1e-6f);
            const f32x4 g = *(const f32x4*)(p.kvn + lane * 4);
            const f32x4 o = v * rstd * g;
            float* od = ri.isS ? p.out + O_CKVS + ((size_t)(ri.b * 64 + ri.t)) * 256 : p.out + O_CKVP + (size_t)row * 256;
            *(f32x4*)(od + lane * 4) = o;
            *(u32x2*)(ckvall + (size_t)kr * 256 + lane * 4) = pk4(o);
        }
        {
            const int i = lane & 31;
            const float x1 = bf2f(kperaw[(size_t)row * 64 + i]), x2 = bf2f(kperaw[(size_t)row * 64 + 32 + i]);
            float c, s; rope_cs(ri.pos, 2 * i, c, s);
            const float o1 = x1 * c - x2 * s, o2 = x1 * s + x2 * c;
            float* od = ri.isS ? p.out + O_KPES + ((size_t)(ri.b * 64 + ri.t)) * 64 : p.out + O_KPEP + (size_t)row * 64;
            if (lane < 32) { od[i] = o1; od[32 + i] = o2; kpeall[(size_t)kr * 64 + i] = f2bf(o1); kpeall[(size_t)kr * 64 + 32 + i] = f2bf(o2); }
        }
    }
}

#define MFMA32(a, b, c) __builtin_amdgcn_mfma_f32_32x32x16_bf16((a), (b), (c), 0, 0, 0)
DI int pi32(int r) { return (r & 0x13) | ((r & 4) << 1) | ((r & 8) >> 1); }
DI int crow(int reg, int hh) { return (reg & 3) + 8 * (reg >> 2) + 4 * hh; }
DI bf16x8 pack8(const float (&v)[8]) {
    u32x4 o; o.x = pk2(v[0], v[1]); o.y = pk2(v[2], v[3]); o.z = pk2(v[4], v[5]); o.w = pk2(v[6], v[7]);
    return __builtin_bit_cast(bf16x8, o);
}
DI f32x16 zero16() { f32x16 z; for (int i = 0; i < 16; ++i) z[i] = 0.f; return z; }

DI void phase2_r1(const Params& p) {
    int tid = threadIdx.x; asm volatile("" : "+v"(tid));
    const int lane = tid & 63, w = __builtin_amdgcn_readfirstlane(tid >> 6), l31 = lane & 31, hh = lane >> 5;
    const bf16_t* rkt = (const bf16_t*)(p.ws + OFF_RKT);
    const bf16_t* rvt = (const bf16_t*)(p.ws + OFF_RVT);
    bf16_t* kvst = (bf16_t*)p.out;
    bf16_t* ss = (bf16_t*)(p.out + O_YS);
    for (int u = blockIdx.x; u < 1056; u += gridDim.x) {
        const bf16_t *ka, *va; size_t ts;
        if (u < 1024) { const int bh = u >> 7, c = u & 127; ka = rkt + (size_t)bh * 128 * 8192 + c * 64; va = rvt + (size_t)bh * 256 * 8192 + c * 64; ts = 8192; }
        else { const int s = u - 1024; ka = rkt + RKT_S + (size_t)s * 128 * 64; va = rvt + RVT_S + (size_t)s * 256 * 64; ts = 64; }
        f32x16 acc[4];
#pragma unroll
        for (int i = 0; i < 4; ++i) acc[i] = zero16();
#pragma unroll
        for (int ks = 0; ks < 4; ++ks) {
            const bf16x8 a = *(const bf16x8*)(va + (size_t)(32 * w + l31) * ts + ks * 16 + hh * 8);
#pragma unroll
            for (int dkt = 0; dkt < 4; ++dkt) {
                const bf16x8 b = *(const bf16x8*)(ka + (size_t)(dkt * 32 + l31) * ts + ks * 16 + hh * 8);
                acc[dkt] = MFMA32(a, b, acc[dkt]);
            }
        }
        if (u < 1024) {
            bf16_t* o = kvst + (size_t)u * 32768;
#pragma unroll
            for (int dkt = 0; dkt < 4; ++dkt)
#pragma unroll
                for (int reg = 0; reg < 16; ++reg) o[(32 * w + crow(reg, hh)) * 128 + dkt * 32 + l31] = f2bf(acc[dkt][reg]);
        } else {
            const int s = u - 1024, h = s & 3;
            const float G = fexp2(64.0f * lg2gamma(h));
            const float* sin_ = p.st + (size_t)s * 32768;
            float* so = p.out + O_STS + (size_t)s * 32768;
            bf16_t* o = ss + (size_t)s * 32768;
#pragma unroll
            for (int dkt = 0; dkt < 4; ++dkt)
#pragma unroll
                for (int reg = 0; reg < 16; ++reg) {
                    const int dv = 32 * w + crow(reg, hh), dk = dkt * 32 + l31;
                    const float sv = sin_[dk * 256 + dv];
                    so[dk * 256 + dv] = G * sv + acc[dkt][reg];
                    o[dv * 128 + dk] = f2bf(sv);
                }
        }
    }
}
DI void phase3_scan(const Params& p) {
    const int gtid = blockIdx.x * NTHREADS + threadIdx.x, nth = gridDim.x * NTHREADS;
    bf16_t* kvst = (bf16_t*)p.out;
    for (int pidx = gtid; pidx < 8 * 16384; pidx += nth) {
        const int bh = pidx >> 14, e = (pidx & 16383) * 2, h = bh & 3;
        const float G = fexp2(64.0f * lg2gamma(h));
        float s0 = 0.f, s1 = 0.f;
        unsigned* ptr = (unsigned*)(kvst + (size_t)bh * 128 * 32768 + e);
#pragma unroll 8
        for (int c = 0; c < 128; ++c) {
            const unsigned v = ptr[(size_t)c * 16384];
            ptr[(size_t)c * 16384] = pk2(s0, s1);
            s0 = G * s0 + __uint_as_float(v << 16); s1 = G * s1 + __uint_as_float(v & 0xffff0000u);
        }
        const int dv = e >> 7, dk = e & 127;
        float* so = p.out + O_STP + (size_t)bh * 32768;
        so[dk * 256 + dv] = s0; so[(dk + 1) * 256 + dv] = s1;
    }
}
DI void phase4_r3(const Params& p) {
    int tid = threadIdx.x; asm volatile("" : "+v"(tid));
    const int lane = tid & 63, w = __builtin_amdgcn_readfirstlane(tid >> 6), l31 = lane & 31, hh = lane >> 5;
    const bf16_t* rq = (const bf16_t*)(p.ws + OFF_RQ);
    const bf16_t* rk = (const bf16_t*)(p.ws + OFF_RK);
    const bf16_t* rvt = (const bf16_t*)(p.ws + OFF_RVT);
    const bf16_t* srg = (const bf16_t*)(p.ws + OFF_SRG);
    bf16_t* retin = (bf16_t*)(p.ws + OFF_RETIN);
    const bf16_t* kvst = (const bf16_t*)p.out;
    const bf16_t* ss = (const bf16_t*)(p.out + O_YS);
    for (int u = blockIdx.x; u < 256 + 32; u += gridDim.x) {
        int h, qh, rowbase; const bf16_t *stp, *vt; size_t ts;
        if (u < 256) { const int bh = u >> 5, c = (u & 31) * 4 + (w >> 1); qh = w & 1; h = bh & 3; rowbase = (bh >> 2) * 8192 + c * 64;
            stp = kvst + (size_t)(bh * 128 + c) * 32768; vt = rvt + (size_t)bh * 256 * 8192 + c * 64; ts = 8192; }
        else { const int s = u - 256; if (w >= 2) continue; qh = w; h = s & 3; rowbase = TP + (s >> 2) * 64;
            stp = ss + (size_t)s * 32768; vt = rvt + RVT_S + (size_t)s * 256 * 64; ts = 64; }
        const int l = qh * 32 + l31;
        const float lg = lg2gamma(h);
        const char* qbase = (const char*)(rq + (size_t)(rowbase + qh * 32) * 512 + h * 128);
        const unsigned qoff = (unsigned)(l31 * 512 + hh * 8) * 2u;
        f32x16 acc[8];
#pragma unroll
        for (int i = 0; i < 8; ++i) acc[i] = zero16();
        const unsigned soff = (unsigned)(l31 * 128 + hh * 8) * 2u;
#pragma unroll
        for (int ks = 0; ks < 8; ++ks) {
            const bf16x8 bq = *(const bf16x8*)(qbase + qoff + ks * 32);
#pragma unroll
            for (int dvt = 0; dvt < 8; ++dvt) {
                const bf16x8 a = *(const bf16x8*)((const char*)stp + soff + dvt * 8192 + ks * 32);
                acc[dvt] = MFMA32(a, bq, acc[dvt]);
            }
        }
        const float qd = fexp2((float)(l + 1) * lg);
#pragma unroll
        for (int dvt = 0; dvt < 8; ++dvt) acc[dvt] *= qd;
        const unsigned voff = (unsigned)(l31 * (unsigned)ts + hh * 8) * 2u;
        const unsigned vstep = (unsigned)ts * 64u;
        const unsigned koff = (unsigned)(pi32(l31) * 512 + hh * 8) * 2u;
        for (int kt = 0; kt <= qh; ++kt) {
            f32x16 s = zero16();
            const char* kbase = (const char*)(rk + (size_t)(rowbase + kt * 32) * 512 + h * 128);
#pragma unroll
            for (int ks = 0; ks < 8; ++ks) { const bf16x8 a = *(const bf16x8*)(kbase + koff + ks * 32); const bf16x8 bq = *(const bf16x8*)(qbase + qoff + ks * 32); s = MFMA32(a, bq, s); }
#pragma unroll
            for (int st = 0; st < 2; ++st) {
                float v[8];
#pragma unroll
                for (int j = 0; j < 8; ++j) {
                    const int reg = 8 * st + j, m = kt * 32 + pi32(crow(reg, hh)), d = l - m;
                    v[j] = d >= 0 ? s[reg] * fexp2((float)d * lg) : 0.f;
                }
                const bf16x8 P = pack8(v);
                const char* vbase = (const char*)vt + (kt * 2 + st) * 32;
#pragma unroll
                for (int dvt = 0; dvt < 8; ++dvt) {
                    const bf16x8 a = *(const bf16x8*)(vbase + voff + dvt * vstep);
                    acc[dvt] = MFMA32(a, P, acc[dvt]);
                }
            }
        }
        float sum = 0.f, sq = 0.f;
#pragma unroll
        for (int dvt = 0; dvt < 8; ++dvt)
#pragma unroll
            for (int r = 0; r < 16; ++r) { const float x = acc[dvt][r]; sum += x; sq += x * x; }
        sum += __shfl_xor(sum, 32); sq += __shfl_xor(sq, 32);
        const float mean = sum * (1.0f / 256.0f);
        const float rstd = rsqrtf(sq * (1.0f / 256.0f) - mean * mean + 1e-6f);
        const size_t orow = (size_t)(rowbase + l) * 1024 + h * 256;
#pragma unroll
        for (int dvt = 0; dvt < 8; ++dvt)
#pragma unroll
            for (int g = 0; g < 4; ++g) {
                const int dv0 = dvt * 32 + 8 * g + 4 * hh;
                const f32x4 gw = *(const f32x4*)(p.gn + h * 256 + dv0);
                const u32x2 gt = *(const u32x2*)(srg + orow + dv0);
                f32x4 o;
                o[0] = (acc[dvt][4 * g + 0] - mean) * rstd * gw[0] * __uint_as_float(gt.x << 16);
                o[1] = (acc[dvt][4 * g + 1] - mean) * rstd * gw[1] * __uint_as_float(gt.x & 0xffff0000u);
                o[2] = (acc[dvt][4 * g + 2] - mean) * rstd * gw[2] * __uint_as_float(gt.y << 16);
                o[3] = (acc[dvt][4 * g + 3] - mean) * rstd * gw[3] * __uint_as_float(gt.y & 0xffff0000u);
                *(u32x2*)(retin + orow + dv0) = pk4(o);
            }
    }
}

DI void epi_q(const Params& p, const f32x4 (&acc)[2][2][4][2], int pm, int tc) {
    EPI_IDS;
    bf16_t* q = (bf16_t*)(p.ws + OFF_Q);
    const float QS = 0.07216878364870322f * 1.4426950408889634f;
    const int row0 = pm * 256 + wr * 64 + fr;
    if (tc < 4) {
#pragma unroll
        for (int ai = 0; ai < 2; ++ai)
#pragma unroll
            for (int m = 0; m < 4; ++m) {
                const int row = row0 + ai * 128 + m * 16;
#pragma unroll
                for (int bj = 0; bj < 2; ++bj)
#pragma unroll
                    for (int n = 0; n < 2; ++n) {
                        const int d = wc * 32 + n * 16 + fq * 4, head = 2 * tc + bj;
                        *(u32x2*)(q + (size_t)row * 1536 + head * 192 + d) = pk4(acc[ai][bj][m][n] * QS);
                    }
            }
    } else {
#pragma unroll
        for (int ai = 0; ai < 2; ++ai)
#pragma unroll
            for (int m = 0; m < 4; ++m) {
                const int row = row0 + ai * 128 + m * 16;
                const RowInfo ri = rinfo(row);
#pragma unroll
                for (int n = 0; n < 2; ++n) {
                    const int i0 = n * 16 + fq * 4, head = 4 * (tc - 4) + wc;
                    const f32x4 x1 = acc[ai][0][m][n], x2 = acc[ai][1][m][n];
                    f32x4 o1, o2;
#pragma unroll
                    for (int j = 0; j < 4; ++j) { float c, s; rope_cs(ri.pos, 2 * (i0 + j), c, s); o1[j] = (x1[j] * c - x2[j] * s) * QS; o2[j] = (x1[j] * s + x2[j] * c) * QS; }
                    *(u32x2*)(q + (size_t)row * 1536 + head * 192 + 128 + i0) = pk4(o1);
                    *(u32x2*)(q + (size_t)row * 1536 + head * 192 + 160 + i0) = pk4(o2);
                }
            }
    }
}
DI void epi_kv(const Params& p, const f32x4 (&acc)[2][2][4][2], int pm, int tc) {
    EPI_IDS;
    bf16_t* knp = (bf16_t*)p.out; bf16_t* vtp = knp + SZ_KNP / 2;
    bf16_t* kns = (bf16_t*)(p.ws + OFF_KNS); bf16_t* vts = (bf16_t*)(p.ws + OFF_VTS);
    const int row0 = pm * 256 + wr * 64 + fr;
#pragma unroll
    for (int ai = 0; ai < 2; ++ai)
#pragma unroll
        for (int m = 0; m < 4; ++m) {
            const int row = row0 + ai * 128 + m * 16;
            int isS, b, t;
            if (row < TP) { isS = 0; b = row >> 13; t = row & 8191; } else { const int r = row - TP; isS = 1; b = r / 2112; t = r - b * 2112; }
#pragma unroll
            for (int bj = 0; bj < 2; ++bj) {
                const int head = 2 * (tc & 3) + bj;
#pragma unroll
                for (int n = 0; n < 2; ++n) {
                    const int d = wc * 32 + n * 16 + fq * 4;
                    if (tc < 4) {
                        bf16_t* dst = isS ? kns + ((size_t)(b * 8 + head) * 2112 + t) * 128 + d : knp + ((size_t)(b * 8 + head) * 8192 + t) * 128 + d;
                        *(u32x2*)dst = pk4(acc[ai][bj][m][n]);
                    } else {
                        bf16_t* dst; size_t ts;
                        if (isS) { dst = vts + ((size_t)(b * 8 + head) * 128 + d) * 2112 + t; ts = 2112; } else { dst = vtp + ((size_t)(b * 8 + head) * 128 + d) * 8192 + t; ts = 8192; }
#pragma unroll
                        for (int j = 0; j < 4; ++j) dst[(size_t)j * ts] = f2bf(acc[ai][bj][m][n][j]);
                    }
                }
            }
        }
}
DI void phase5_gemms(const Params& p, LAS unsigned char* shm) {
    const int nq = 66 * 6, nkv = 130 * 8;
    for (int L = blockIdx.x; L < nq + nkv; L += gridDim.x) {
        f32x4 acc[2][2][4][2]; ZERO_ACC(acc);
        int pm, pn;
        if (L < nkv) {
            tile_order(L, 130, 8, pm, pn);
            gemm_kloop(acc, (const bf16_t*)(p.ws + OFF_CKVALL), 256, false, (const bf16_t*)(p.ws + OFF_WUKV), 256, 4, pm * 256, pn * 256, shm);
            epi_kv(p, acc, pm, pn);
        } else {
            tile_order(L - nkv, 66, 6, pm, pn);
            gemm_kloop(acc, (const bf16_t*)(p.ws + OFF_CQ), 512, false, (const bf16_t*)(p.ws + OFF_WUQ), 512, 8, pm * 256, pn * 256, shm);
            epi_q(p, acc, pm, pn);
        }
    }
}

DI void phase6_attn(const Params& p, LAS unsigned char* lds) {
    int tid = threadIdx.x; asm volatile("" : "+v"(tid));
    const int lane = tid & 63, w = __builtin_amdgcn_readfirstlane(tid >> 6), l31 = lane & 31, hh = lane >> 5;
    unsigned* ctr = (unsigned*)(p.ws + OFF_CTR);
    bf16_t* q = (bf16_t*)(p.ws + OFF_Q);
    const bf16_t* knp = (const bf16_t*)p.out; const bf16_t* vtp = knp + SZ_KNP / 2;
    const bf16_t* kns = (const bf16_t*)(p.ws + OFF_KNS); const bf16_t* vts = (const bf16_t*)(p.ws + OFF_VTS);
    const bf16_t* kpeall = (const bf16_t*)(p.ws + OFF_KPEALL);
    constexpr int KB = 25600, VB = 18432, VOFF = 2 * KB, UOFF = VOFF + 2 * VB;
    for (;;) {
        if (tid == 0) *(LAS unsigned*)(lds + UOFF) = atomicAdd(ctr, 1u);
        __syncthreads();
        const int u = (int)*(LAS unsigned*)(lds + UOFF);
        __syncthreads();
        if (u >= 576) break;
        int h, rowq0, nkt, limit, Tk; bool active; const bf16_t *kn, *kpe, *vt;
        if (u < 512) { const int qb = 31 - (u >> 4), bh = u & 15, b = bh >> 3; h = bh & 7; rowq0 = b * 8192 + qb * 256; nkt = 4 * qb + 4; limit = 4 * qb + (w >> 1); active = true; Tk = 8192;
            kn = knp + (size_t)bh * 8192 * 128; kpe = kpeall + (size_t)b * 8192 * 64; vt = vtp + (size_t)bh * 128 * 8192; }
        else { const int su = u - 512, b = su >> 3; h = su & 7; rowq0 = TP + b * 64; nkt = 33; limit = 32; active = w < 2; Tk = 2112;
            kn = kns + (size_t)su * 2112 * 128; kpe = kpeall + (size_t)(TP + b * 2112) * 64; vt = vts + (size_t)su * 128 * 2112; }
        bf16x8 Bq[12];
        bf16_t* qrow = q + (size_t)(rowq0 + 32 * w + l31) * 1536 + h * 192;
        if (active) {
#pragma unroll
            for (int ks = 0; ks < 12; ++ks) Bq[ks] = *(const bf16x8*)(qrow + ks * 16 + hh * 8);
        } else {
#pragma unroll
            for (int ks = 0; ks < 12; ++ks) Bq[ks] = (bf16x8){0, 0, 0, 0, 0, 0, 0, 0};
        }
        f32x16 o[4];
#pragma unroll
        for (int i = 0; i < 4; ++i) o[i] = zero16();
        float mrun = -INFINITY, lsum = 0.f;
        const int kr0 = tid >> 4, kc0 = tid & 15;
        const int pr = tid >> 3, pc = tid & 7;
        u32x4 g[5];
#define ATT_LOAD(kt) do { \
            g[0] = *(const u32x4*)(kn + ((size_t)((kt) * 64 + kr0) * 128 + kc0 * 8)); \
            g[1] = *(const u32x4*)(kn + ((size_t)((kt) * 64 + kr0 + 32) * 128 + kc0 * 8)); \
            g[2] = *(const u32x4*)(kpe + ((size_t)((kt) * 64 + pr) * 64 + pc * 8)); \
            g[3] = *(const u32x4*)(vt + ((size_t)pr * Tk + (kt) * 64 + pc * 8)); \
            g[4] = *(const u32x4*)(vt + ((size_t)(pr + 64) * Tk + (kt) * 64 + pc * 8)); } while (0)
#define ATT_STORE(buf) do { \
            *(LAS u32x4*)(lds + (buf) * KB + kr0 * 400 + kc0 * 16) = g[0]; \
            *(LAS u32x4*)(lds + (buf) * KB + (kr0 + 32) * 400 + kc0 * 16) = g[1]; \
            *(LAS u32x4*)(lds + (buf) * KB + pr * 400 + 256 + pc * 16) = g[2]; \
            *(LAS u32x4*)(lds + VOFF + (buf) * VB + pr * 144 + pc * 16) = g[3]; \
            *(LAS u32x4*)(lds + VOFF + (buf) * VB + (pr + 64) * 144 + pc * 16) = g[4]; } while (0)
        ATT_LOAD(0);
        ATT_STORE(0);
        __syncthreads();
        const int koff = pi32(l31) * 400 + hh * 16, voff = l31 * 144 + hh * 16;
        for (int kt = 0; kt < nkt; ++kt) {
            const int buf = kt & 1;
            if (kt + 1 < nkt) ATT_LOAD(kt + 1);
            if (active && kt <= limit) {
                const LAS unsigned char* kb = lds + buf * KB + koff;
                const LAS unsigned char* vb = lds + VOFF + buf * VB + voff;
                f32x16 s[2];
#pragma unroll
                for (int sub = 0; sub < 2; ++sub) {
                    s[sub] = zero16();
#pragma unroll
                    for (int ks = 0; ks < 12; ++ks) { const bf16x8 a = *(const LAS bf16x8*)(kb + sub * 32 * 400 + ks * 32); s[sub] = MFMA32(a, Bq[ks], s[sub]); }
                }
                float mx = s[0][0];
#pragma unroll
                for (int r = 0; r < 16; ++r) { mx = fmaxf(mx, s[0][r]); mx = fmaxf(mx, s[1][r]); }
                mx = fmaxf(mx, __shfl_xor(mx, 32));
                const float mnew = fmaxf(mrun, mx);
                const float alpha = fexp2(mrun - mnew);
                mrun = mnew;
                float ps = 0.f;
                bf16x8 P[4];
#pragma unroll
                for (int sub = 0; sub < 2; ++sub)
#pragma unroll
                    for (int st = 0; st < 2; ++st) {
                        float v[8];
#pragma unroll
                        for (int j = 0; j < 8; ++j) { v[j] = fexp2(s[sub][8 * st + j] - mnew); ps += v[j]; }
                        P[sub * 2 + st] = pack8(v);
                    }
                lsum = lsum * alpha + ps;
#pragma unroll
                for (int dvt = 0; dvt < 4; ++dvt) o[dvt] *= alpha;
#pragma unroll
                for (int dvt = 0; dvt < 4; ++dvt)
#pragma unroll
                    for (int kk = 0; kk < 4; ++kk) { const bf16x8 a = *(const LAS bf16x8*)(vb + dvt * 32 * 144 + kk * 32); o[dvt] = MFMA32(a, P[kk], o[dvt]); }
            }
            if (kt + 1 < nkt) ATT_STORE(buf ^ 1);
            __syncthreads();
        }
        if (active) {
            const float ltot = lsum + __shfl_xor(lsum, 32);
            const float inv = 1.0f / ltot;
#pragma unroll
            for (int dvt = 0; dvt < 4; ++dvt)
#pragma unroll
                for (int g4 = 0; g4 < 4; ++g4) {
                    f32x4 v; v[0] = o[dvt][4 * g4] * inv; v[1] = o[dvt][4 * g4 + 1] * inv; v[2] = o[dvt][4 * g4 + 2] * inv; v[3] = o[dvt][4 * g4 + 3] * inv;
                    *(u32x2*)(qrow + dvt * 32 + 8 * g4 + 4 * hh) = pk4(v);
                }
        }
    }
}

template <int PASS>
DI void phase8_pass(const Params& p, LAS unsigned char* shm) {
    const bf16_t* sg = (const bf16_t*)(p.ws + (PASS == 0 ? OFF_SGA : OFF_SGB));
    bf16_t* merged = (bf16_t*)(p.ws + OFF_MERGED);
    for (int L = blockIdx.x;; L += gridDim.x) {
        int pm, pn; if (!tile_order(L, 66, 4, pm, pn)) break;
        f32x4 acc[2][2][4][2]; ZERO_ACC(acc);
        if (PASS == 0) gemm_kloop(acc, (const bf16_t*)(p.ws + OFF_RETIN), 1024, false, (const bf16_t*)(p.ws + OFF_WRO), 1024, 16, pm * 256, pn * 256, shm);
        else gemm_kloop(acc, (const bf16_t*)(p.ws + OFF_Q), 1536, true, (const bf16_t*)(p.ws + OFF_WMO), 1024, 16, pm * 256, pn * 256, shm);
        EPI_IDS;
        const int row0 = pm * 256 + wr * 64 + fr;
#pragma unroll
        for (int ai = 0; ai < 2; ++ai)
#pragma unroll
            for (int m = 0; m < 4; ++m) {
                const size_t rbase = (size_t)(row0 + ai * 128 + m * 16) * 1024 + pn * 256 + wc * 32 + fq * 4;
#pragma unroll
                for (int bj = 0; bj < 2; ++bj)
#pragma unroll
                    for (int n = 0; n < 2; ++n) {
                        const size_t idx = rbase + bj * 128 + n * 16;
                        const u32x2 b = *(const u32x2*)(sg + idx);
                        f32x4 r; r[0] = __uint_as_float(b.x << 16); r[1] = __uint_as_float(b.x & 0xffff0000u); r[2] = __uint_as_float(b.y << 16); r[3] = __uint_as_float(b.y & 0xffff0000u);
                        f32x4 o = acc[ai][bj][m][n] * r;
                        if (PASS == 1) {
                            const u32x2 t = *(const u32x2*)(merged + idx);
                            o[0] += __uint_as_float(t.x << 16); o[1] += __uint_as_float(t.x & 0xffff0000u); o[2] += __uint_as_float(t.y << 16); o[3] += __uint_as_float(t.y & 0xffff0000u);
                        }
                        *(u32x2*)(merged + idx) = pk4(o);
                    }
            }
    }
}
DI void phase8_merge(const Params& p, LAS unsigned char* shm) { phase8_pass<0>(p, shm); phase8_pass<1>(p, shm); }
DI float* hrow(const Params& p, int row) { return row < TP ? p.out + O_YP + (size_t)row * 1024 : p.out + O_YS + (size_t)(row - TP) * 1024; }
DI void phase9_out(const Params& p, LAS unsigned char* shm) {
    for (int L = blockIdx.x;; L += gridDim.x) {
        int pm, pn; if (!tile_order(L, 66, 4, pm, pn)) break;
        f32x4 acc[2][2][4][2]; ZERO_ACC(acc);
        gemm_kloop(acc, (const bf16_t*)(p.ws + OFF_MERGED), 1024, false, (const bf16_t*)(p.ws + OFF_WOUT), 1024, 16, pm * 256, pn * 256, shm);
        EPI_IDS;
        const int row0 = pm * 256 + wr * 64 + fr;
#pragma unroll
        for (int ai = 0; ai < 2; ++ai)
#pragma unroll
            for (int m = 0; m < 4; ++m) {
                const int row = row0 + ai * 128 + m * 16;
                const float* xr = row < TP ? p.x_p + (size_t)row * 1024 : p.x_s + (size_t)(row - TP) * 1024;
                float* hr = hrow(p, row);
#pragma unroll
                for (int bj = 0; bj < 2; ++bj)
#pragma unroll
                    for (int n = 0; n < 2; ++n) {
                        const int c = pn * 256 + bj * 128 + wc * 32 + n * 16 + fq * 4;
                        *(f32x4*)(hr + c) = *(const f32x4*)(xr + c) + acc[ai][bj][m][n];
                    }
            }
    }
}
DI void phase10_hn(const Params& p) {
    const int gtid = blockIdx.x * NTHREADS + threadIdx.x, nth = gridDim.x * NTHREADS;
    const int gw = gtid >> 6, nw = nth >> 6, lane = threadIdx.x & 63;
    bf16_t* hn = (bf16_t*)(p.ws + OFF_HN);
    for (int row = gw; row < TALL; row += nw) rmsnorm_row_1024(hrow(p, row), p.nffn, hn + (size_t)row * 1024, lane);
}
DI void phase11_gu(const Params& p, LAS unsigned char* shm) {
    bf16_t* act = (bf16_t*)(p.ws + OFF_ACT);
    for (int L = blockIdx.x;; L += gridDim.x) {
        int pm, pn; if (!tile_order(L, 66, 22, pm, pn)) break;
        f32x4 acc[2][2][4][2]; ZERO_ACC(acc);
        gemm_kloop(acc, (const bf16_t*)(p.ws + OFF_HN), 1024, false, (const bf16_t*)(p.ws + OFF_WGU), 1024, 16, pm * 256, pn * 256, shm);
        EPI_IDS;
        const int row0 = pm * 256 + wr * 64 + fr;
#pragma unroll
        for (int ai = 0; ai < 2; ++ai)
#pragma unroll
            for (int m = 0; m < 4; ++m)
#pragma unroll
                for (int n = 0; n < 2; ++n) {
                    const f32x4 g = acc[ai][0][m][n], u = acc[ai][1][m][n];
                    f32x4 o;
#pragma unroll
                    for (int j = 0; j < 4; ++j) o[j] = siluf_(g[j]) * u[j];
                    *(u32x2*)(act + (size_t)(row0 + ai * 128 + m * 16) * 2816 + pn * 128 + wc * 32 + n * 16 + fq * 4) = pk4(o);
                }
    }
}
DI void phase12_down(const Params& p, LAS unsigned char* shm) {
    for (int L = blockIdx.x;; L += gridDim.x) {
        int pm, pn; if (!tile_order(L, 66, 4, pm, pn)) break;
        f32x4 acc[2][2][4][2]; ZERO_ACC(acc);
        gemm_kloop(acc, (const bf16_t*)(p.ws + OFF_ACT), 2816, false, (const bf16_t*)(p.ws + OFF_WDN), 2816, 44, pm * 256, pn * 256, shm);
        EPI_IDS;
        const int row0 = pm * 256 + wr * 64 + fr;
#pragma unroll
        for (int ai = 0; ai < 2; ++ai)
#pragma unroll
            for (int m = 0; m < 4; ++m) {
                float* hr = hrow(p, row0 + ai * 128 + m * 16);
#pragma unroll
                for (int bj = 0; bj < 2; ++bj)
#pragma unroll
                    for (int n = 0; n < 2; ++n) {
                        const int c = pn * 256 + bj * 128 + wc * 32 + n * 16 + fq * 4;
                        *(f32x4*)(hr + c) = *(const f32x4*)(hr + c) + acc[ai][bj][m][n];
                    }
            }
    }
}
DI void phase13_final(const Params& p) {
    const int gtid = blockIdx.x * NTHREADS + threadIdx.x, nth = gridDim.x * NTHREADS;
    const int gw = gtid >> 6, nw = nth >> 6, lane = threadIdx.x & 63;
    for (int row = gw; row < TALL; row += nw) {
        float* x = hrow(p, row);
        f32x4 v[4]; float ss = 0.f;
#pragma unroll
        for (int i = 0; i < 4; ++i) { v[i] = *(const f32x4*)(x + i * 256 + lane * 4); ss += v[i][0] * v[i][0] + v[i][1] * v[i][1] + v[i][2] * v[i][2] + v[i][3] * v[i][3]; }
        ss = wave_sum(ss);
        const float rstd = rsqrtf(ss * (1.0f / 1024.0f) + 1e-6f);
#pragma unroll
        for (int i = 0; i < 4; ++i) { const f32x4 gg = *(const f32x4*)(p.nfin + i * 256 + lane * 4); *(f32x4*)(x + i * 256 + lane * 4) = v[i] * rstd * gg; }
    }
}

__global__ void __launch_bounds__(NTHREADS) fwd_megakernel(Params p) {
    extern __shared__ __attribute__((aligned(16))) unsigned char smem[];
    cg::grid_group grid = cg::this_grid();
    LAS unsigned char* shm = (LAS unsigned char*)smem;
#ifndef PMASK
#define PMASK 0xffff
#endif
#define PH(k) if ((PMASK >> (k)) & 1)
    PH(0) phase0(p);
    grid.sync();
    PH(1) phase_gemm_in(p, 0, 16, shm);
    grid.sync();
    PH(2) { phase2_elem(p); phase2_r1(p); }
    grid.sync();
    PH(3) phase3_scan(p);
    grid.sync();
    PH(4) phase4_r3(p);
    grid.sync();
    PH(5) phase5_gemms(p, shm);
    grid.sync();
    PH(6) phase6_attn(p, shm);
    grid.sync();
    PH(7) phase_gemm_in(p, 16, 8, shm);
    grid.sync();
    PH(8) phase8_merge(p, shm);
    grid.sync();
    PH(9) phase9_out(p, shm);
    grid.sync();
    PH(10) phase10_hn(p);
    grid.sync();
    PH(11) phase11_gu(p, shm);
    grid.sync();
    PH(12) phase12_down(p, shm);
    grid.sync();
    PH(13) phase13_final(p);
}

extern "C" void kernel_launch(void* const* d_in, const int* in_sizes, int n_in, void* d_out, int out_size, void* d_ws, size_t ws_size,
                              hipStream_t stream) {
    constexpr size_t kDynLds = 131072;
    static int grid_blocks = 0;
    if (!grid_blocks) {
        int dev = 0, cus = 0, per_cu = 0;
        hipGetDevice(&dev);
        hipDeviceGetAttribute(&cus, hipDeviceAttributeMultiprocessorCount, dev);
        hipFuncSetAttribute((const void*)fwd_megakernel, hipFuncAttributeMaxDynamicSharedMemorySize, (int)kDynLds);
        hipOccupancyMaxActiveBlocksPerMultiprocessor(&per_cu, fwd_megakernel, NTHREADS, kDynLds);
        if (per_cu < 1) per_cu = 1;
        grid_blocks = cus;
    }
    Params p{};
    const float** pp = (const float**)&p;
    for (int i = 0; i < 19; ++i) pp[i] = (const float*)d_in[i];
    p.out = (float*)d_out; p.ws = (char*)d_ws;
    void* args[] = {&p};
    hipError_t e = hipLaunchCooperativeKernel((void*)fwd_megakernel, dim3(grid_blocks), dim3(NTHREADS), args, kDynLds, stream);
    if (e != hipSuccess) fprintf(stderr, "cooperative launch failed: %s (grid %d)\n", hipGetErrorString(e), grid_blocks);
}
```

```cpp
#include <hip/hip_runtime.h>
#include <hip/hip_cooperative_groups.h>
#include <cstdio>
#include <cstdint>
namespace cg = cooperative_groups;

typedef unsigned short bf16_t;
typedef short bf16x8 __attribute__((ext_vector_type(8)));
typedef float f32x4 __attribute__((ext_vector_type(4)));
typedef float f32x2 __attribute__((ext_vector_type(2)));
typedef float f32x16 __attribute__((ext_vector_type(16)));
typedef unsigned u32x4 __attribute__((ext_vector_type(4)));
typedef unsigned u32x2 __attribute__((ext_vector_type(2)));
typedef __bf16 bf16v2 __attribute__((ext_vector_type(2)));
#define DI __device__ __forceinline__

#ifndef PROBE_DOUBLE
#define PROBE_DOUBLE -1
#endif

constexpr int TP = 16384, TS = 512, TALL = 16896;
constexpr int NKV = 33280;
constexpr int NTHREADS = 512;

constexpr size_t SZ_WIN = 6144ull * 1024 * 2, SZ_WUQ = 1536ull * 512 * 2, SZ_WUKV = 2048ull * 256 * 2, SZ_W1K = 1024ull * 1024 * 2,
                 SZ_WGU = 5632ull * 1024 * 2, SZ_WDN = 1024ull * 2816 * 2;
constexpr size_t OFF_WIN = 0, OFF_WUQ = OFF_WIN + SZ_WIN, OFF_WUKV = OFF_WUQ + SZ_WUQ, OFF_WRO = OFF_WUKV + SZ_WUKV, OFF_WMO = OFF_WRO + SZ_W1K,
                 OFF_WOUT = OFF_WMO + SZ_W1K, OFF_WGU = OFF_WOUT + SZ_W1K, OFF_WDN = OFF_WGU + SZ_WGU;
constexpr size_t SZ_T1K = (size_t)TALL * 1024 * 2, SZ_T512 = (size_t)TALL * 512 * 2;
constexpr size_t OFF_XN = OFF_WDN + SZ_WDN;
constexpr size_t OFF_CKVALL = OFF_XN + SZ_T1K, SZ_CKVALL = (size_t)NKV * 256 * 2;
constexpr size_t OFF_KPEALL = OFF_CKVALL + SZ_CKVALL, SZ_KPEALL = (size_t)NKV * 64 * 2;
constexpr size_t OFF_POOL = OFF_KPEALL + SZ_KPEALL;
constexpr size_t OFF_CQ = OFF_POOL;
constexpr size_t OFF_RETIN = OFF_CQ + SZ_T512;
constexpr size_t OFF_CKVRAW = OFF_RETIN, OFF_KPERAW = OFF_CKVRAW + (size_t)TALL * 256 * 2;
constexpr size_t OFF_BIG = OFF_RETIN + SZ_T1K;
constexpr size_t OFF_RQ = OFF_BIG, OFF_RK = OFF_RQ + SZ_T512, OFF_RKT = OFF_RK + SZ_T512, OFF_RVT = OFF_RKT + SZ_T512, OFF_SRG = OFF_RVT + SZ_T1K;
constexpr size_t SZ_Q = (size_t)TALL * 1536 * 2, SZ_KNS = 8ull * 8 * 2112 * 128 * 2;
constexpr size_t OFF_Q = OFF_BIG, OFF_KNS = OFF_Q + SZ_Q, OFF_VTS = OFF_KNS + SZ_KNS;
constexpr size_t OFF_SGA = OFF_KNS, OFF_SGB = OFF_VTS;
constexpr size_t OFF_MERGED = OFF_XN, OFF_HN = OFF_CQ, OFF_ACT = OFF_BIG;
constexpr size_t OFF_CTR = OFF_BIG + 3 * SZ_T512 + 2 * SZ_T1K;
constexpr size_t OFF_BAR = OFF_CTR + 4096;
constexpr size_t OFF_ROWSS = OFF_CTR + 65536;
constexpr size_t OFF_PCNT = OFF_CTR + 32768;
constexpr size_t OFF_XBUF = OFF_CTR + 196608;
static_assert(OFF_XBUF + 64 * 4 * 256 * 4 <= 268435456ull, "xbuf");
static_assert(OFF_VTS + SZ_KNS == OFF_CTR, "mla overlay must match retention overlay");
static_assert(OFF_CTR + 65536 + 16896 * 4 <= 268435456ull, "workspace overflow");
constexpr size_t RKT_S = 2ull * 4 * 128 * 8192, RVT_S = 2ull * 4 * 256 * 8192;
constexpr size_t O_YP = 0, O_YS = 16777216, O_CKVP = 17301504, O_KPEP = 21495808, O_STP = 22544384, O_CKVS = 22806528, O_KPES = 22937600, O_STS = 22970368;
constexpr size_t SZ_KNP = 2ull * 8 * 8192 * 128 * 2;

__device__ const double THETA_REV[64] = {
0.15915494309189535, 0.13782250260398285, 0.11934937021124886, 0.10335229661843406, 0.08949940160889101, 0.07750328875537406, 0.06711508300522726, 0.058119267441876246, 0.050329212104487035, 0.04358330210530733, 0.03774158471741977, 0.032682865872357, 0.0283021958306234, 0.024508691862069852, 0.02122365276477766, 0.018378926105679667, 0.015915494309189534, 0.013782250260398284, 0.011934937021124886, 0.010335229661843406, 0.008949940160889102, 0.0077503288755374055, 0.006711508300522725, 0.005811926744187624, 0.005032921210448704, 0.004358330210530733, 0.003774158471741977, 0.0032682865872356993, 0.00283021958306234, 0.002450869186206985, 0.0021223652764777662, 0.0018378926105679667, 0.0015915494309189536, 0.0013782250260398288, 0.0011934937021124885, 0.0010335229661843405, 0.0008949940160889102, 0.0007750328875537405, 0.0006711508300522726, 0.0005811926744187624, 0.0005032921210448703, 0.0004358330210530733, 0.00037741584717419774, 0.0003268286587235699, 0.00028302195830623395, 0.00024508691862069854, 0.0002122365276477766, 0.00018378926105679666, 0.00015915494309189535, 0.00013782250260398286, 0.00011934937021124886, 0.00010335229661843406, 8.949940160889102e-05, 7.750328875537406e-05, 6.711508300522725e-05, 5.811926744187624e-05, 5.0329212104487035e-05, 4.358330210530732e-05, 3.774158471741978e-05, 3.2682865872357e-05, 2.8302195830623396e-05, 2.4508691862069852e-05, 2.122365276477766e-05, 1.8378926105679668e-05};

struct Params {
    const float *x_p, *x_s, *c_ckv, *c_kpe, *st, *nmix, *w_in, *qn, *w_uq, *kvn, *w_ukv, *gn, *w_ro, *w_mo, *w_out, *nffn, *w_gu, *w_dn, *nfin;
    float* out;
    char* ws;
};

DI float bf2f(bf16_t h) { return __uint_as_float((unsigned)h << 16); }
DI unsigned pk2(float lo, float hi) {
    f32x2 v = {lo, hi};
    bf16v2 b = __builtin_convertvector(v, bf16v2);
    return __builtin_bit_cast(unsigned, b);
}
DI bf16_t f2bf(float x) { return (bf16_t)(pk2(x, 0.f) & 0xffffu); }
DI u32x2 pk4(f32x4 v) { u32x2 r; r.x = pk2(v[0], v[1]); r.y = pk2(v[2], v[3]); return r; }
DI float fexp2(float x) { return __builtin_amdgcn_exp2f(x); }
DI float frcp(float x) { return __builtin_amdgcn_rcpf(x); }
DI float sigmoidf_(float x) { return frcp(1.0f + fexp2(-1.44269504089f * x)); }
DI float siluf_(float x) { return x * sigmoidf_(x); }
typedef unsigned u32v2_t __attribute__((ext_vector_type(2)));
DI float xhalf_max(float v) { const u32v2_t r = __builtin_amdgcn_permlane32_swap(__float_as_uint(v), __float_as_uint(v), false, false); return fmaxf(__uint_as_float(r.x), __uint_as_float(r.y)); }
DI float xhalf_sum(float v) { const u32v2_t r = __builtin_amdgcn_permlane32_swap(__float_as_uint(v), __float_as_uint(v), false, false); return __uint_as_float(r.x) + __uint_as_float(r.y); }
DI float wave_sum(float v) {
#pragma unroll
    for (int o = 32; o >= 1; o >>= 1) v += __shfl_xor(v, o);
    return v;
}
DI void rope_cs(int pos, int i, float& c, float& s) {
    double r = (double)pos * THETA_REV[i];
    r = r - __builtin_floor(r);
    const float rf = (float)r;
    s = __builtin_amdgcn_sinf(rf);
    c = __builtin_amdgcn_cosf(rf);
}
DI float lg2gamma(int h) { return h == 0 ? -0.04580368961312479f : h == 1 ? -0.02272007650008353f : h == 2 ? -0.011315313227834146f : -0.005646563141142063f; }
struct RowInfo { int isS, b, t, pos; };
DI RowInfo rinfo(int row) {
    RowInfo r;
    if (row < TP) { r.isS = 0; r.b = row >> 13; r.t = row & 8191; r.pos = r.t; }
    else { const int q = row - TP; r.isS = 1; r.b = q >> 6; r.t = q & 63; r.pos = 2048 + r.t; }
    return r;
}
DI int kvrow(const RowInfo& ri, int row) { return ri.isS ? (TP + ri.b * 2112 + 2048 + ri.t) : row; }

constexpr int BM = 256, BK = 64, HALF = 128, HT = HALF * BK;
DI int lds_byte(int r, int c) {
    int st = (r >> 4) * 2 + (c >> 5), rr = r & 15, cc = c & 31, ob = rr * 64 + cc * 2;
    return st * 1024 + (ob ^ (((ob >> 9) & 1) << 5));
}
DI void stage_rc(int b, int& R, int& C) {
    int st = b / 1024, sb = b % 1024, swz = sb ^ (((sb >> 9) & 1) << 5);
    R = (st >> 1) * 16 + swz / 64; C = (st & 1) * 32 + (swz % 64) / 2;
}
DI bool tile_order(int L, int nM, int nN, int& pm, int& pn) {
    const int nwg = nM * nN;
    if (L >= nwg) return false;
    int wgid = L;
    { const int q = nwg / 8, r = nwg % 8, xcd = wgid % 8, off = wgid / 8; wgid = (xcd < r ? xcd * (q + 1) : r * (q + 1) + (xcd - r) * q) + off; }
    const int nig = 8 * nN, gid = wgid / nig, fm = gid * 8, gsz = (nM - fm) < 8 ? (nM - fm) : 8;
    pm = fm + ((wgid % nig) % gsz); pn = (wgid % nig) / gsz;
    return true;
}

#define LAS __attribute__((address_space(3)))
DI void gemm_kloop(f32x4 (&acc)[2][2][4][2], const bf16_t* __restrict__ A, int lda, bool a192, const bf16_t* __restrict__ Bt, int ldb, int nt,
                   int brow, int bcol, LAS unsigned char* lds) {
    int tid = threadIdx.x; asm volatile("" : "+v"(tid));
    const int wid = __builtin_amdgcn_readfirstlane(tid >> 6), lane = tid & 63, wr = wid >> 2, wc = wid & 3, fr = lane & 15, fq = lane >> 4;
    unsigned voffA[2], voffB[2];
#pragma unroll
    for (int i = 0; i < 2; ++i) { int R, C; stage_rc(tid * 16 + i * 8192, R, C); voffA[i] = (unsigned)(R * lda + C) * 2u; voffB[i] = (unsigned)(R * ldb + C) * 2u; }
    const size_t hstepA = (size_t)HALF * lda * 2, hstepB = (size_t)HALF * ldb * 2;
    const unsigned ldsw = (unsigned)wid * 1024u;
    const int aoff = lds_byte(wr * 64 + fr, fq * 8), boff = lds_byte(wc * 32 + fr, fq * 8);
    const char* cA = (const char*)A + (size_t)brow * lda * 2;
    const char* cB = (const char*)Bt + (size_t)bcol * ldb * 2;
    constexpr int HTB = HALF * BK * 2;
#define SA(b, h) (((b) * 2 + (h)) * HTB)
#define SB(b, h) ((4 + (b) * 2 + (h)) * HTB)
#define AKO(kt) ((size_t)(a192 ? (((kt) >> 1) * 192 + ((kt) & 1) * 64) : (kt) * 64) * 2)
#define STAGE_(bufoff, gbase, voff) do { _Pragma("unroll") for (int _i = 0; _i < 2; ++_i) \
      __builtin_amdgcn_global_load_lds((const unsigned*)((const char*)(gbase) + (voff)[_i]), (LAS unsigned*)(lds + (bufoff) + ldsw + _i * 8192), 16, 0, 0); } while (0)
#define STAGEA(buf, h, kt) STAGE_(buf, cA + (h) * hstepA + AKO(kt), voffA)
#define STAGEB(buf, h, kt) STAGE_(buf, cB + (h) * hstepB + (size_t)(kt) * 128, voffB)
#define LDA(dst, b, h) do { _Pragma("unroll") for (int m = 0; m < 4; ++m) _Pragma("unroll") for (int k = 0; k < 2; ++k) dst[m][k] = *(const LAS bf16x8*)(lds + SA(b, h) + aoff + m * 2048 + k * 1024); } while (0)
#define LDB(dst, b, h) do { _Pragma("unroll") for (int n = 0; n < 2; ++n) _Pragma("unroll") for (int k = 0; k < 2; ++k) dst[n][k] = *(const LAS bf16x8*)(lds + SB(b, h) + boff + n * 2048 + k * 1024); } while (0)
#define MMA(ai, bj, At_, Bt_) do { __builtin_amdgcn_s_setprio(1); _Pragma("unroll") for (int m = 0; m < 4; ++m) _Pragma("unroll") for (int n = 0; n < 2; ++n) _Pragma("unroll") for (int k = 0; k < 2; ++k) \
      acc[ai][bj][m][n] = __builtin_amdgcn_mfma_f32_16x16x32_bf16(Bt_[n][k], At_[m][k], acc[ai][bj][m][n], 0, 0, 0); \
    __builtin_amdgcn_s_setprio(0); } while (0)
#define WAIT_V(n) asm volatile("s_waitcnt vmcnt(" #n ")" ::: "memory")
#define WAIT_L(n) asm volatile("s_waitcnt lgkmcnt(" #n ")" ::: "memory")
#define BAR __builtin_amdgcn_s_barrier()
#define SCHED __builtin_amdgcn_sched_barrier(0)
    bf16x8 At[4][2], B0[2][2], B1[2][2];
    WAIT_V(0);
    STAGEB(SB(0, 0), 0, 0); STAGEA(SA(0, 0), 0, 0);
    STAGEB(SB(0, 1), 1, 0); STAGEA(SA(0, 1), 1, 0);
    if (wr == 1) BAR;
    WAIT_V(4); BAR;
    STAGEB(SB(1, 0), 0, 1); STAGEA(SA(1, 0), 0, 1); STAGEB(SB(1, 1), 1, 1);
    WAIT_V(6); BAR;
    for (int t = 0; t < nt - 2; t += 2) {
        LDB(B0, 0, 0); SCHED; LDA(At, 0, 0); STAGEA(SA(1, 1), 1, t + 1);
        WAIT_L(8); BAR; WAIT_L(0); MMA(0, 0, At, B0); BAR; SCHED;
        LDB(B1, 0, 1); STAGEB(SB(0, 0), 0, t + 2);
        BAR; WAIT_L(0); MMA(0, 1, At, B1); BAR;
        LDA(At, 0, 1); STAGEA(SA(0, 0), 0, t + 2);
        BAR; WAIT_L(0); MMA(1, 0, At, B0); BAR; SCHED;
        STAGEB(SB(0, 1), 1, t + 2);
        WAIT_V(6); BAR; MMA(1, 1, At, B1); BAR;
        LDB(B0, 1, 0); SCHED; LDA(At, 1, 0); STAGEA(SA(0, 1), 1, t + 2);
        WAIT_L(8); BAR; WAIT_L(0); MMA(0, 0, At, B0); BAR; SCHED;
        LDB(B1, 1, 1); STAGEB(SB(1, 0), 0, t + 3);
        BAR; WAIT_L(0); MMA(0, 1, At, B1); BAR;
        LDA(At, 1, 1); STAGEA(SA(1, 0), 0, t + 3);
        BAR; WAIT_L(0); MMA(1, 0, At, B0); BAR; SCHED;
        STAGEB(SB(1, 1), 1, t + 3);
        WAIT_V(6); BAR; MMA(1, 1, At, B1); BAR;
    }
    { LDB(B0, 0, 0); LDA(At, 0, 0); STAGEA(SA(1, 1), 1, nt - 1);
      BAR; WAIT_L(0); MMA(0, 0, At, B0); BAR;
      LDB(B1, 0, 1); BAR; WAIT_L(0); MMA(0, 1, At, B1); BAR;
      LDA(At, 0, 1); WAIT_V(4); BAR; WAIT_L(0); MMA(1, 0, At, B0); MMA(1, 1, At, B1); BAR; }
    { LDB(B0, 1, 0); LDA(At, 1, 0); WAIT_V(2); BAR; WAIT_L(0); MMA(0, 0, At, B0); BAR;
      LDB(B1, 1, 1); WAIT_V(0); BAR; WAIT_L(0); MMA(0, 1, At, B1); BAR;
      LDA(At, 1, 1); BAR; WAIT_L(0); MMA(1, 0, At, B0); MMA(1, 1, At, B1); BAR; }
    if (wr == 0) BAR;
}
#define ZERO_ACC(acc) for (int a_ = 0; a_ < 2; ++a_) for (int b_ = 0; b_ < 2; ++b_) for (int m_ = 0; m_ < 4; ++m_) for (int n_ = 0; n_ < 2; ++n_) acc[a_][b_][m_][n_] = (f32x4){0.f, 0.f, 0.f, 0.f}
struct GUnit { const bf16_t* a; const bf16_t* b; int pm, pn; };
template <class Sched, class Epi>
DI void gemm_stream(LAS unsigned char* lds, int lda, bool a192, int ldb, int nt, const Sched& S, const Epi& E) {
    int tid = threadIdx.x; asm volatile("" : "+v"(tid));
    const int wid = __builtin_amdgcn_readfirstlane(tid >> 6), lane = tid & 63, wr = wid >> 2, wc = wid & 3, fr = lane & 15, fq = lane >> 4;
    GUnit cur, nxt; int ui = 0;
    if (!S.next(0, cur)) return;
    unsigned voffA[2], voffB[2];
#pragma unroll
    for (int i = 0; i < 2; ++i) { int R, C; stage_rc(tid * 16 + i * 8192, R, C); voffA[i] = (unsigned)(R * lda + C) * 2u; voffB[i] = (unsigned)(R * ldb + C) * 2u; }
    const size_t hstepA = (size_t)HALF * lda * 2, hstepB = (size_t)HALF * ldb * 2;
    const unsigned ldsw = (unsigned)wid * 1024u;
    const int aoff = lds_byte(wr * 64 + fr, fq * 8), boff = lds_byte(wc * 32 + fr, fq * 8);
    constexpr int HTB = HALF * BK * 2;
#define GS_STAGE(bufoff, gbase, voff) do { _Pragma("unroll") for (int _i = 0; _i < 2; ++_i) \
      __builtin_amdgcn_global_load_lds((const unsigned*)((const char*)(gbase) + (voff)[_i]), (LAS unsigned*)(lds + (bufoff) + ldsw + _i * 8192), 16, 0, 0); } while (0)
    f32x4 acc[2][2][4][2];
    ZERO_ACC(acc);
    bf16x8 At[4][2], B0[2][2], B1[2][2];
    const char* cA = (const char*)cur.a; const char* cB = (const char*)cur.b;
    WAIT_V(0);
    GS_STAGE(SB(0, 0), cB, voffB); GS_STAGE(SA(0, 0), cA, voffA); GS_STAGE(SB(0, 1), cB + hstepB, voffB); GS_STAGE(SA(0, 1), cA + hstepA, voffA);
    if (wr == 1) BAR;
    WAIT_V(4); BAR;
    GS_STAGE(SB(1, 0), cB + 128, voffB); GS_STAGE(SA(1, 0), cA + 128, voffA); GS_STAGE(SB(1, 1), cB + hstepB + 128, voffB);
    WAIT_V(6); BAR;
    for (;;) {
        const bool has_next = S.next(ui + 1, nxt);
        const char* nA = has_next ? (const char*)nxt.a : cA; const char* nB = has_next ? (const char*)nxt.b : cB;
        for (int t = 0; t < nt; t += 2) {
            const bool last = (t == nt - 2);
            const char* a1 = cA + AKO(t + 1);
            const char* a2 = last ? nA : cA + AKO(t + 2); const char* b2 = last ? nB : cB + (size_t)(t + 2) * 128;
            const char* a3 = a2 + 128; const char* b3 = b2 + 128;
            LDB(B0, 0, 0); SCHED; LDA(At, 0, 0); GS_STAGE(SA(1, 1), a1 + hstepA, voffA);
            WAIT_L(8); BAR; WAIT_L(0); MMA(0, 0, At, B0); BAR; SCHED;
            LDB(B1, 0, 1); GS_STAGE(SB(0, 0), b2, voffB);
            BAR; WAIT_L(0); MMA(0, 1, At, B1); BAR;
            LDA(At, 0, 1); GS_STAGE(SA(0, 0), a2, voffA);
            BAR; WAIT_L(0); MMA(1, 0, At, B0); BAR; SCHED;
            GS_STAGE(SB(0, 1), b2 + hstepB, voffB);
            WAIT_V(6); BAR; MMA(1, 1, At, B1); BAR;
            LDB(B0, 1, 0); SCHED; LDA(At, 1, 0); GS_STAGE(SA(0, 1), a2 + hstepA, voffA);
            WAIT_L(8); BAR; WAIT_L(0); MMA(0, 0, At, B0); BAR; SCHED;
            LDB(B1, 1, 1); GS_STAGE(SB(1, 0), b3, voffB);
            BAR; WAIT_L(0); MMA(0, 1, At, B1); BAR;
            LDA(At, 1, 1); GS_STAGE(SA(1, 0), a3, voffA);
            BAR; WAIT_L(0); MMA(1, 0, At, B0); BAR; SCHED;
            GS_STAGE(SB(1, 1), b3 + hstepB, voffB);
            WAIT_V(6); BAR; MMA(1, 1, At, B1); BAR;
        }
        E(acc, cur);
        if (!has_next) break;
        ZERO_ACC(acc);
        cur = nxt; cA = nA; cB = nB; ++ui;
    }
    WAIT_V(0);
    if (wr == 0) BAR;
    BAR;
#undef GS_STAGE
}
#define EPI_IDS int lane = threadIdx.x & 63, wid = __builtin_amdgcn_readfirstlane(threadIdx.x >> 6); asm volatile("" : "+v"(lane), "+s"(wid)); const int wr = wid >> 2, wc = wid & 3, fr = lane & 15, fq = lane >> 4

template <class F>
DI void conv_w(const float* __restrict__ W, int K, int Norig, bf16_t* __restrict__ Wt, int Nt, F perm, LAS unsigned char* lds) {
    int tid = threadIdx.x; asm volatile("" : "+v"(tid));
    const int lane = tid & 63, w = tid >> 6, nl = tid >> 3, ch = tid & 7;
    const int ntn = Nt / 64, total = (K / 64) * ntn;
    float v[8], vn[8];
    int t = blockIdx.x;
    if (t < total) {
        const int tn = t % ntn, tk = t / ntn, col = perm(tn * 64 + lane);
#pragma unroll
        for (int j = 0; j < 8; ++j) v[j] = col >= 0 ? W[(size_t)(tk * 64 + w * 8 + j) * Norig + col] : 0.f;
    }
    for (; t < total; t += gridDim.x) {
        const int t2 = t + gridDim.x;
        if (t2 < total) {
            const int tn = t2 % ntn, tk = t2 / ntn, col = perm(tn * 64 + lane);
#pragma unroll
            for (int j = 0; j < 8; ++j) vn[j] = col >= 0 ? W[(size_t)(tk * 64 + w * 8 + j) * Norig + col] : 0.f;
        }
        const int tn = t % ntn, tk = t / ntn;
        __syncthreads();
        u32x4 o; o.x = pk2(v[0], v[1]); o.y = pk2(v[2], v[3]); o.z = pk2(v[4], v[5]); o.w = pk2(v[6], v[7]);
        *(LAS u32x4*)(lds + lane * 144 + w * 16) = o;
        __syncthreads();
        *(u32x4*)(Wt + (size_t)(tn * 64 + nl) * K + tk * 64 + ch * 8) = *(const LAS u32x4*)(lds + nl * 144 + ch * 16);
#pragma unroll
        for (int j = 0; j < 8; ++j) v[j] = vn[j];
    }
    __syncthreads();
}
DI int perm_win(int n) {
    const int tc = n >> 8, c = n & 255;
    if (tc < 4) { const int half = c >> 7, e = (c >> 6) & 1, i = c & 63; return (tc >> 1) * 512 + (2 * (tc & 1) + e) * 128 + half * 64 + i; }
    if (tc < 15) return n;
    if (tc == 15) return c < 64 ? 3840 + c : -1;
    return 3904 + (n - 4096);
}
DI int perm_wuq(int n) {
    const int tc = n >> 8, c = n & 255;
    if (tc < 4) { const int e = c >> 7, d = c & 127; return (2 * tc + e) * 192 + d; }
    const int half = c >> 7, e = (c >> 5) & 3, i = c & 31;
    return (4 * (tc - 4) + e) * 192 + 128 + half * 32 + i;
}
DI int perm_wukv(int n) {
    const int tc = n >> 8, c = n & 255;
    const int e = c >> 7, d = c & 127;
    if (tc < 4) return (2 * tc + e) * 256 + d;
    return (2 * (tc - 4) + e) * 256 + 128 + d;
}
DI int perm_wgu(int n) { const int tc = n >> 8, c = n & 255; return (c >> 7) * 2816 + tc * 128 + (c & 127); }
DI int perm_id(int n) { return n; }

DI void rmsnorm_row_1024(const float* __restrict__ x, const float* __restrict__ g, bf16_t* __restrict__ o, int lane) {
    f32x4 v[4]; float ss = 0.f;
#pragma unroll
    for (int i = 0; i < 4; ++i) { v[i] = *(const f32x4*)(x + i * 256 + lane * 4); ss += v[i][0] * v[i][0] + v[i][1] * v[i][1] + v[i][2] * v[i][2] + v[i][3] * v[i][3]; }
    ss = wave_sum(ss);
    const float rstd = rsqrtf(ss * (1.0f / 1024.0f) + 1e-6f);
#pragma unroll
    for (int i = 0; i < 4; ++i) { const f32x4 gg = *(const f32x4*)(g + i * 256 + lane * 4); *(u32x2*)(o + i * 256 + lane * 4) = pk4(v[i] * rstd * gg); }
}

DI void rmsnorm_row2_1024(const float* __restrict__ xa, const float* __restrict__ xb, const float* __restrict__ g, bf16_t* __restrict__ oa, bf16_t* __restrict__ ob, int lane) {
    f32x4 va[4], vb[4]; float sa = 0.f, sb = 0.f;
#pragma unroll
    for (int i = 0; i < 4; ++i) { va[i] = *(const f32x4*)(xa + i * 256 + lane * 4); vb[i] = *(const f32x4*)(xb + i * 256 + lane * 4); }
#pragma unroll
    for (int i = 0; i < 4; ++i) { sa += va[i][0] * va[i][0] + va[i][1] * va[i][1] + va[i][2] * va[i][2] + va[i][3] * va[i][3]; sb += vb[i][0] * vb[i][0] + vb[i][1] * vb[i][1] + vb[i][2] * vb[i][2] + vb[i][3] * vb[i][3]; }
    sa = wave_sum(sa); sb = wave_sum(sb);
    const float ra = rsqrtf(sa * (1.0f / 1024.0f) + 1e-6f), rb = rsqrtf(sb * (1.0f / 1024.0f) + 1e-6f);
#pragma unroll
    for (int i = 0; i < 4; ++i) { const f32x4 gg = *(const f32x4*)(g + i * 256 + lane * 4); *(u32x2*)(oa + i * 256 + lane * 4) = pk4(va[i] * ra * gg); *(u32x2*)(ob + i * 256 + lane * 4) = pk4(vb[i] * rb * gg); }
}

DI void phase0(const Params& p, LAS unsigned char* lds) {
    const int gtid = blockIdx.x * NTHREADS + threadIdx.x, nth = gridDim.x * NTHREADS;
    char* ws = p.ws;
    if (gtid < 64) ((unsigned*)(ws + OFF_CTR))[gtid] = (gtid == 33) ? 1u : 0u;
    conv_w(p.w_in, 1024, 5952, (bf16_t*)(ws + OFF_WIN), 6144, perm_win, lds);
    conv_w(p.w_uq, 512, 1536, (bf16_t*)(ws + OFF_WUQ), 1536, perm_wuq, lds);
    conv_w(p.w_ukv, 256, 2048, (bf16_t*)(ws + OFF_WUKV), 2048, perm_wukv, lds);
    conv_w(p.w_ro, 1024, 1024, (bf16_t*)(ws + OFF_WRO), 1024, perm_id, lds);
    conv_w(p.w_mo, 1024, 1024, (bf16_t*)(ws + OFF_WMO), 1024, perm_id, lds);
    conv_w(p.w_out, 1024, 1024, (bf16_t*)(ws + OFF_WOUT), 1024, perm_id, lds);
    conv_w(p.w_gu, 1024, 5632, (bf16_t*)(ws + OFF_WGU), 5632, perm_wgu, lds);
    conv_w(p.w_dn, 2816, 1024, (bf16_t*)(ws + OFF_WDN), 1024, perm_id, lds);
    const int gw = gtid >> 6, nw = nth >> 6, lane = threadIdx.x & 63;
    bf16_t* xn = (bf16_t*)(ws + OFF_XN);
    for (int row = gw; row < TALL; row += 2 * nw) {
        const int row2 = row + nw;
        const float* x = row < TP ? p.x_p + (size_t)row * 1024 : p.x_s + (size_t)(row - TP) * 1024;
        if (row2 < TALL) {
            const float* x2 = row2 < TP ? p.x_p + (size_t)row2 * 1024 : p.x_s + (size_t)(row2 - TP) * 1024;
            rmsnorm_row2_1024(x, x2, p.nmix, xn + (size_t)row * 1024, xn + (size_t)row2 * 1024, lane);
        } else rmsnorm_row_1024(x, p.nmix, xn + (size_t)row * 1024, lane);
    }
    bf16_t* ckvall = (bf16_t*)(ws + OFF_CKVALL); bf16_t* kpeall = (bf16_t*)(ws + OFF_KPEALL);
    for (int idx = gtid; idx < 8 * 2048 * 64; idx += nth) {
        const int c4 = idx & 63, r = idx >> 6, b = r >> 11, j = r & 2047;
        const f32x4 v = *(const f32x4*)(p.c_ckv + (size_t)r * 256 + c4 * 4);
        *(u32x2*)(ckvall + (size_t)(TP + b * 2112 + j) * 256 + c4 * 4) = pk4(v);
    }
    for (int idx = gtid; idx < 8 * 2048 * 16; idx += nth) {
        const int c4 = idx & 15, r = idx >> 4, b = r >> 11, j = r & 2047;
        const f32x4 v = *(const f32x4*)(p.c_kpe + (size_t)r * 64 + c4 * 4);
        *(u32x2*)(kpeall + (size_t)(TP + b * 2112 + j) * 64 + c4 * 4) = pk4(v);
    }
}

DI void epi_win(const Params& p, const f32x4 (&acc)[2][2][4][2], int pm, int tc) {
    EPI_IDS;
    char* ws = p.ws;
    const int row0 = pm * 256 + wr * 64 + fr;
    if (tc < 4) {
        const bool isK = tc >= 2;
        bf16_t* nat = (bf16_t*)(ws + (isK ? OFF_RK : OFF_RQ));
        const float sc = isK ? 0.08838834764831845f : 1.0f;
#pragma unroll
        for (int ai = 0; ai < 2; ++ai)
#pragma unroll
            for (int m = 0; m < 4; ++m) {
                const int row = row0 + ai * 128 + m * 16;
                const RowInfo ri = rinfo(row);
#pragma unroll
                for (int n = 0; n < 2; ++n) {
                    const int cw = wc * 32 + n * 16 + fq * 4, e = cw >> 6, i0 = cw & 63, head = 2 * (tc & 1) + e;
                    const f32x4 x1 = acc[ai][0][m][n], x2 = acc[ai][1][m][n];
                    f32x4 o1, o2;
#pragma unroll
                    for (int j = 0; j < 4; ++j) { float c, s; rope_cs(ri.pos, i0 + j, c, s); o1[j] = (x1[j] * c - x2[j] * s) * sc; o2[j] = (x1[j] * s + x2[j] * c) * sc; }
                    *(u32x2*)(nat + (size_t)row * 512 + head * 128 + i0) = pk4(o1);
                    *(u32x2*)(nat + (size_t)row * 512 + head * 128 + 64 + i0) = pk4(o2);
                }
            }
    } else {
        bf16_t* dst; int ld, cbase, act = 0;
        if (tc < 12) { dst = (bf16_t*)(ws + OFF_SRG); ld = 1024; cbase = (tc - 8) * 256; act = 1; }
        else if (tc < 14) { dst = (bf16_t*)(ws + OFF_CQ); ld = 512; cbase = (tc - 12) * 256; }
        else if (tc == 14) { dst = (bf16_t*)(ws + OFF_CKVRAW); ld = 256; cbase = 0; }
        else if (tc == 15) { dst = (bf16_t*)(ws + OFF_KPERAW); ld = 64; cbase = 0; }
        else if (tc < 20) { dst = (bf16_t*)(ws + OFF_SGA); ld = 1024; cbase = (tc - 16) * 256; act = 2; }
        else { dst = (bf16_t*)(ws + OFF_SGB); ld = 1024; cbase = (tc - 20) * 256; act = 2; }
#pragma unroll
        for (int ai = 0; ai < 2; ++ai)
#pragma unroll
            for (int m = 0; m < 4; ++m) {
                const int row = row0 + ai * 128 + m * 16;
#pragma unroll
                for (int bj = 0; bj < 2; ++bj)
#pragma unroll
                    for (int n = 0; n < 2; ++n) {
                        const int c = bj * 128 + wc * 32 + n * 16 + fq * 4;
                        if (tc == 15 && c >= 64) continue;
                        f32x4 v = acc[ai][bj][m][n];
                        if (act == 1) { for (int j = 0; j < 4; ++j) v[j] = siluf_(v[j]); }
                        else if (act == 2) { for (int j = 0; j < 4; ++j) v[j] = sigmoidf_(v[j]); }
                        *(u32x2*)(dst + (size_t)row * ld + cbase + c) = pk4(v);
                    }
            }
    }
}
DI void epi_win_T(const Params& p, const f32x4 (&acc)[2][2][4][2], int pm, int tc) {
    EPI_IDS;
    char* ws = p.ws;
    if (tc < 4) {
        bf16_t* rkt = (bf16_t*)(ws + OFF_RKT);
        const int head = 2 * (tc & 1) + wr;
        const float lg = lg2gamma(head), sc = 0.08838834764831845f;
#pragma unroll
        for (int bj = 0; bj < 2; ++bj)
#pragma unroll
            for (int n = 0; n < 2; ++n) {
                const int tok0 = pm * 256 + bj * 128 + wc * 32 + n * 16 + fq * 4;
                const RowInfo ri = rinfo(tok0);
                bf16_t* dst = ri.isS ? rkt + RKT_S + (size_t)(ri.b * 4 + head) * 8192 + ri.t
                                     : rkt + ((size_t)(ri.b * 4 + head) * 128 + (ri.t >> 6)) * 8192 + (ri.t & 63);
                f32x4 dec;
#pragma unroll
                for (int j = 0; j < 4; ++j) dec[j] = sc * fexp2((float)(63 - ((ri.t + j) & 63)) * lg);
#pragma unroll
                for (int m = 0; m < 4; ++m) {
                    const int i = m * 16 + fr;
                    const f32x4 x1 = acc[0][bj][m][n], x2 = acc[1][bj][m][n];
                    f32x4 o1, o2;
#pragma unroll
                    for (int j = 0; j < 4; ++j) { float c, s; rope_cs(ri.pos + j, i, c, s); o1[j] = (x1[j] * c - x2[j] * s) * dec[j]; o2[j] = (x1[j] * s + x2[j] * c) * dec[j]; }
                    *(u32x2*)(dst + i * 64) = pk4(o1);
                    *(u32x2*)(dst + (64 + i) * 64) = pk4(o2);
                }
            }
    } else {
        bf16_t* rvt = (bf16_t*)(ws + OFF_RVT);
        const int head = tc - 4;
#pragma unroll
        for (int bj = 0; bj < 2; ++bj)
#pragma unroll
            for (int n = 0; n < 2; ++n) {
                const int tok0 = pm * 256 + bj * 128 + wc * 32 + n * 16 + fq * 4;
                const RowInfo ri = rinfo(tok0);
                bf16_t* dst = ri.isS ? rvt + RVT_S + (size_t)(ri.b * 4 + head) * 16384 + ri.t
                                     : rvt + ((size_t)(ri.b * 4 + head) * 128 + (ri.t >> 6)) * 16384 + (ri.t & 63);
#pragma unroll
                for (int ai = 0; ai < 2; ++ai)
#pragma unroll
                    for (int m = 0; m < 4; ++m) *(u32x2*)(dst + (ai * 128 + wr * 64 + m * 16 + fr) * 64) = pk4(acc[ai][bj][m][n]);
            }
    }
}
DI void phase_gemm_in(const Params& p, int tc0, int ntc, LAS unsigned char* shm, int nM = TALL / 256) {
    const bf16_t* A = (const bf16_t*)(p.ws + OFF_XN);
    const bf16_t* Bt = (const bf16_t*)(p.ws + OFF_WIN);
    for (int L = blockIdx.x;; L += gridDim.x) {
        int pm, pn; if (!tile_order(L, nM, ntc, pm, pn)) break;
        f32x4 acc[2][2][4][2]; ZERO_ACC(acc);
        gemm_kloop(acc, A, 1024, false, Bt, 1024, 16, pm * 256, (tc0 + pn) * 256, shm);
        epi_win(p, acc, pm, tc0 + pn);
    }
}

DI void phase7_gates(const Params& p, LAS unsigned char* shm) {
    const bf16_t* A = (const bf16_t*)(p.ws + OFF_XN);
    const bf16_t* Bt = (const bf16_t*)(p.ws + OFF_WIN);
#pragma unroll 1
    for (int g = 0; g < 2; ++g)
        for (int L = blockIdx.x;; L += gridDim.x) {
            int pm, pn; if (!tile_order(L, 64, 4, pm, pn)) break;
            const int tc = 16 + 4 * g + pn;
            f32x4 acc[2][2][4][2]; ZERO_ACC(acc);
            gemm_kloop(acc, A, 1024, false, Bt, 1024, 16, pm * 256, tc * 256, shm);
            epi_win(p, acc, pm, tc);
        }
}
struct SchedP1 {
    const bf16_t* X; const bf16_t* W;
    DI bool next(int i, GUnit& u) const {
        int pm, pn; if (!tile_order(blockIdx.x + i * gridDim.x, TALL / 256, 18, pm, pn)) return false;
        u.pm = pm; u.pn = pn;
        if (pn < 12) { const int tc = pn < 4 ? pn : pn + 4; u.a = X + (size_t)pm * 256 * 1024; u.b = W + (size_t)tc * 256 * 1024; }
        else { const int tc = pn - 10; u.a = W + (size_t)tc * 256 * 1024; u.b = X + (size_t)pm * 256 * 1024; }
        return true;
    }
};
struct EpiP1 {
    Params p;
    DI void operator()(const f32x4 (&acc)[2][2][4][2], const GUnit& u) const {
        if (u.pn < 12) epi_win(p, acc, u.pm, u.pn < 4 ? u.pn : u.pn + 4); else epi_win_T(p, acc, u.pm, u.pn - 10);
    }
};
DI void phase1_gemm(const Params& p, LAS unsigned char* shm) {
    const SchedP1 S{(const bf16_t*)(p.ws + OFF_XN), (const bf16_t*)(p.ws + OFF_WIN)};
    const EpiP1 E{p};
    gemm_stream(shm, 1024, false, 1024, 16, S, E);
}

DI void phase2_elem(const Params& p) {
    const int skip = gridDim.x > 64 ? 32 : 0;
    if ((int)blockIdx.x < skip) return;
    const int gw = ((int)blockIdx.x - skip) * 8 + (threadIdx.x >> 6), nw = ((int)gridDim.x - skip) * 8, lane = threadIdx.x & 63;
    char* ws = p.ws;
    bf16_t* cq = (bf16_t*)(ws + OFF_CQ);
    const bf16_t* ckvraw = (const bf16_t*)(ws + OFF_CKVRAW);
    const bf16_t* kperaw = (const bf16_t*)(ws + OFF_KPERAW);
    bf16_t* ckvall = (bf16_t*)(ws + OFF_CKVALL); bf16_t* kpeall = (bf16_t*)(ws + OFF_KPEALL);
    for (int row = gw; row < TALL; row += nw) {
        const RowInfo ri = rinfo(row);
        const int kr = kvrow(ri, row);
        {
            const u32x4 raw = *(const u32x4*)(cq + (size_t)row * 512 + lane * 8);
            float v[8];
#pragma unroll
            for (int j = 0; j < 4; ++j) { v[2 * j] = __uint_as_float(raw[j] << 16); v[2 * j + 1] = __uint_as_float(raw[j] & 0xffff0000u); }
            float ss = 0.f;
#pragma unroll
            for (int j = 0; j < 8; ++j) ss += v[j] * v[j];
            ss = wave_sum(ss);
            const float rstd = rsqrtf(ss * (1.0f / 512.0f) + 1e-6f);
            const f32x4 g0 = *(const f32x4*)(p.qn + lane * 8), g1 = *(const f32x4*)(p.qn + lane * 8 + 4);
            u32x4 o; o.x = pk2(v[0] * rstd * g0[0], v[1] * rstd * g0[1]); o.y = pk2(v[2] * rstd * g0[2], v[3] * rstd * g0[3]);
            o.z = pk2(v[4] * rstd * g1[0], v[5] * rstd * g1[1]); o.w = pk2(v[6] * rstd * g1[2], v[7] * rstd * g1[3]);
            *(u32x4*)(cq + (size_t)row * 512 + lane * 8) = o;
        }
        {
            const u32x2 raw = *(const u32x2*)(ckvraw + (size_t)row * 256 + lane * 4);
            f32x4 v; v[0] = __uint_as_float(raw.x << 16); v[1] = __uint_as_float(raw.x & 0xffff0000u); v[2] = __uint_as_float(raw.y << 16); v[3] = __uint_as_float(raw.y & 0xffff0000u);
            float ss = v[0] * v[0] + v[1] * v[1] + v[2] * v[2] + v[3] * v[3];
            ss = wave_sum(ss);
            const float rstd = rsqrtf(ss * (1.0f / 256.0f) + 1e-6f);
            const f32x4 g = *(const f32x4*)(p.kvn + lane * 4);
            const f32x4 o = v * rstd * g;
            float* od = ri.isS ? p.out + O_CKVS + ((size_t)(ri.b * 64 + ri.t)) * 256 : p.out + O_CKVP + (size_t)row * 256;
            *(f32x4*)(od + lane * 4) = o;
            *(u32x2*)(ckvall + (size_t)kr * 256 + lane * 4) = pk4(o);
        }
        {
            const int i = lane & 31;
            const float x1 = bf2f(kperaw[(size_t)row * 64 + i]), x2 = bf2f(kperaw[(size_t)row * 64 + 32 + i]);
            float c, s; rope_cs(ri.pos, 2 * i, c, s);
            const float o1 = x1 * c - x2 * s, o2 = x1 * s + x2 * c;
            float* od = ri.isS ? p.out + O_KPES + ((size_t)(ri.b * 64 + ri.t)) * 64 : p.out + O_KPEP + (size_t)row * 64;
            if (lane < 32) { od[i] = o1; od[32 + i] = o2; kpeall[(size_t)kr * 64 + i] = f2bf(o1); kpeall[(size_t)kr * 64 + 32 + i] = f2bf(o2); }
        }
    }
}

#define MFMA32(a, b, c) __builtin_amdgcn_mfma_f32_32x32x16_bf16((a), (b), (c), 0, 0, 0)
DI int pi32(int r) { return (r & 0x13) | ((r & 4) << 1) | ((r & 8) >> 1); }
DI int crow(int reg, int hh) { return (reg & 3) + 8 * (reg >> 2) + 4 * hh; }
DI bf16x8 pack8(const float (&v)[8]) {
    u32x4 o; o.x = pk2(v[0], v[1]); o.y = pk2(v[2], v[3]); o.z = pk2(v[4], v[5]); o.w = pk2(v[6], v[7]);
    return __builtin_bit_cast(bf16x8, o);
}
DI f32x16 zero16() { f32x16 z; for (int i = 0; i < 16; ++i) z[i] = 0.f; return z; }

DI void phase2_r1(const Params& p) {
    int tid = threadIdx.x; asm volatile("" : "+v"(tid));
    const int lane = tid & 63, w = __builtin_amdgcn_readfirstlane(tid >> 6), l31 = lane & 31, hh = lane >> 5;
    const bf16_t* rkt = (const bf16_t*)(p.ws + OFF_RKT);
    const bf16_t* rvt = (const bf16_t*)(p.ws + OFF_RVT);
    bf16_t* kvst = (bf16_t*)p.out;
    bf16_t* ss = (bf16_t*)(p.out + O_YS);
    for (int u = blockIdx.x; u < 1056; u += gridDim.x) {
        const bf16_t *ka, *va; size_t ts;
        ts = 64;
        if (u < 1024) { ka = rkt + (size_t)u * 8192; va = rvt + (size_t)u * 16384; }
        else { const int s = u - 1024; ka = rkt + RKT_S + (size_t)s * 8192; va = rvt + RVT_S + (size_t)s * 16384; }
        f32x16 acc[4];
#pragma unroll
        for (int i = 0; i < 4; ++i) acc[i] = zero16();
#define R1_LOAD(A_, B_, ks) do { A_ = *(const bf16x8*)(va + (size_t)(32 * w + l31) * ts + (ks) * 16 + hh * 8); \
            _Pragma("unroll") for (int dkt = 0; dkt < 4; ++dkt) B_[dkt] = *(const bf16x8*)(ka + (size_t)(dkt * 32 + l31) * ts + (ks) * 16 + hh * 8); } while (0)
#define R1_MMA(A_, B_) do { _Pragma("unroll") for (int dkt = 0; dkt < 4; ++dkt) acc[dkt] = MFMA32(B_[dkt], A_, acc[dkt]); } while (0)
        bf16x8 a0, a1, b0[4], b1[4];
        R1_LOAD(a0, b0, 0);
        __builtin_amdgcn_sched_barrier(0);
        R1_LOAD(a1, b1, 1); R1_MMA(a0, b0);
        __builtin_amdgcn_sched_barrier(0);
        R1_LOAD(a0, b0, 2); R1_MMA(a1, b1);
        __builtin_amdgcn_sched_barrier(0);
        R1_LOAD(a1, b1, 3); R1_MMA(a0, b0);
        __builtin_amdgcn_sched_barrier(0);
        R1_MMA(a1, b1);
        if (u < 1024) {
            bf16_t* o = kvst + (size_t)u * 32768;
#pragma unroll
            for (int dkt = 0; dkt < 4; ++dkt)
#pragma unroll
                for (int g = 0; g < 4; ++g) {
                    f32x4 v; v[0] = acc[dkt][4 * g]; v[1] = acc[dkt][4 * g + 1]; v[2] = acc[dkt][4 * g + 2]; v[3] = acc[dkt][4 * g + 3];
                    *(u32x2*)(o + (32 * w + l31) * 128 + dkt * 32 + 8 * g + 4 * hh) = pk4(v);
                }
        } else {
            const int s = u - 1024, h = s & 3;
            const float G = fexp2(64.0f * lg2gamma(h));
            const float* sin_ = p.st + (size_t)s * 32768;
            float* so = p.out + O_STS + (size_t)s * 32768;
            bf16_t* o = ss + (size_t)s * 32768;
#pragma unroll
            for (int dkt = 0; dkt < 4; ++dkt) {
                float sv[16];
#pragma unroll
                for (int reg = 0; reg < 16; ++reg) sv[reg] = sin_[(dkt * 32 + crow(reg, hh)) * 256 + 32 * w + l31];
#pragma unroll
                for (int reg = 0; reg < 16; ++reg) so[(dkt * 32 + crow(reg, hh)) * 256 + 32 * w + l31] = G * sv[reg] + acc[dkt][reg];
#pragma unroll
                for (int g = 0; g < 4; ++g) {
                    f32x4 v; v[0] = sv[4 * g]; v[1] = sv[4 * g + 1]; v[2] = sv[4 * g + 2]; v[3] = sv[4 * g + 3];
                    *(u32x2*)(o + (32 * w + l31) * 128 + dkt * 32 + 8 * g + 4 * hh) = pk4(v);
                }
            }
        }
    }
}
DI void phase3_scan(const Params& p) {
    const int gtid = blockIdx.x * NTHREADS + threadIdx.x, nth = gridDim.x * NTHREADS;
    bf16_t* kvst = (bf16_t*)p.out;
    for (int pidx = gtid; pidx < 8 * 16384; pidx += nth) {
        const int bh = pidx >> 14, e = (pidx & 16383) * 2, h = bh & 3;
        const float G = fexp2(64.0f * lg2gamma(h));
        float s0 = 0.f, s1 = 0.f;
        unsigned* ptr = (unsigned*)(kvst + (size_t)bh * 128 * 32768 + e);
#pragma unroll 1
        for (int c0 = 0; c0 < 128; c0 += 32) {
            unsigned v[32];
#pragma unroll
            for (int i = 0; i < 32; ++i) v[i] = ptr[(size_t)(c0 + i) * 16384];
#pragma unroll
            for (int i = 0; i < 32; ++i) {
                ptr[(size_t)(c0 + i) * 16384] = pk2(s0, s1);
                s0 = G * s0 + __uint_as_float(v[i] << 16); s1 = G * s1 + __uint_as_float(v[i] & 0xffff0000u);
            }
        }
        const int dv = e >> 7, dk = e & 127;
        float* so = p.out + O_STP + (size_t)bh * 32768;
        so[dk * 256 + dv] = s0; so[(dk + 1) * 256 + dv] = s1;
    }
}
DI f32x4 unpk4_(u32x2 b) { f32x4 r; r[0] = __uint_as_float(b.x << 16); r[1] = __uint_as_float(b.x & 0xffff0000u); r[2] = __uint_as_float(b.y << 16); r[3] = __uint_as_float(b.y & 0xffff0000u); return r; }
DI void r3_sample_unit(const Params& p, int s, LAS unsigned char* lds) {
    int tid = threadIdx.x; asm volatile("" : "+v"(tid));
    const int lane = tid & 63, w = __builtin_amdgcn_readfirstlane(tid >> 6), l31 = lane & 31, hh = lane >> 5;
    const bf16_t* rq = (const bf16_t*)(p.ws + OFF_RQ);
    const bf16_t* rk = (const bf16_t*)(p.ws + OFF_RK);
    const bf16_t* srg = (const bf16_t*)(p.ws + OFF_SRG);
    bf16_t* retin = (bf16_t*)(p.ws + OFF_RETIN);
    const int qh = w & 1, dq = w >> 1, h = s & 3, rowbase = TP + (s >> 2) * 64;
    const bf16_t* stp = (const bf16_t*)(p.out + O_YS) + (size_t)s * 32768 + (size_t)dq * 64 * 128;
    const bf16_t* vt = (const bf16_t*)(p.ws + OFF_RVT) + RVT_S + (size_t)s * 16384 + (size_t)dq * 64 * 64;
    const int l = qh * 32 + l31;
    const float lg = lg2gamma(h);
    const char* qbase = (const char*)(rq + (size_t)(rowbase + qh * 32) * 512 + h * 128);
    const unsigned qoff = (unsigned)(l31 * 512 + hh * 8) * 2u;
    f32x16 acc[2]; acc[0] = zero16(); acc[1] = zero16();
    const unsigned soff = (unsigned)(l31 * 128 + hh * 8) * 2u;
#pragma unroll
    for (int ks = 0; ks < 8; ++ks) {
        const bf16x8 bq = *(const bf16x8*)(qbase + qoff + ks * 32);
#pragma unroll
        for (int t = 0; t < 2; ++t) { const bf16x8 a = *(const bf16x8*)((const char*)stp + soff + t * 8192 + ks * 32); acc[t] = MFMA32(a, bq, acc[t]); }
    }
    const float qd = fexp2((float)(l + 1) * lg);
    acc[0] *= qd; acc[1] *= qd;
    const unsigned voff = (unsigned)(l31 * 64 + hh * 8) * 2u;
    const unsigned koff = (unsigned)(pi32(l31) * 512 + hh * 8) * 2u;
    for (int kt = 0; kt <= qh; ++kt) {
        f32x16 sc = zero16();
        const char* kbase = (const char*)(rk + (size_t)(rowbase + kt * 32) * 512 + h * 128);
#pragma unroll
        for (int ks = 0; ks < 8; ++ks) { const bf16x8 a = *(const bf16x8*)(kbase + koff + ks * 32); const bf16x8 bq = *(const bf16x8*)(qbase + qoff + ks * 32); sc = MFMA32(a, bq, sc); }
#pragma unroll
        for (int st = 0; st < 2; ++st) {
            float v[8];
#pragma unroll
            for (int j = 0; j < 8; ++j) { const int reg = 8 * st + j, m = kt * 32 + pi32(crow(reg, hh)), d = l - m; v[j] = d >= 0 ? sc[reg] * fexp2((float)d * lg) : 0.f; }
            const bf16x8 P = pack8(v);
            const char* vbase = (const char*)vt + (kt * 2 + st) * 32;
#pragma unroll
            for (int t = 0; t < 2; ++t) { const bf16x8 a = *(const bf16x8*)(vbase + voff + t * 4096); acc[t] = MFMA32(a, P, acc[t]); }
        }
    }
    float sum = 0.f, sq = 0.f;
#pragma unroll
    for (int t = 0; t < 2; ++t)
#pragma unroll
        for (int r = 0; r < 16; ++r) { const float x = acc[t][r]; sum += x; sq += x * x; }
    sum = xhalf_sum(sum); sq = xhalf_sum(sq);
    LAS f32x2* part = (LAS f32x2*)lds;
    __syncthreads();
    if (hh == 0) part[w * 32 + l31] = (f32x2){sum, sq};
    __syncthreads();
    sum = 0.f; sq = 0.f;
#pragma unroll
    for (int j = 0; j < 4; ++j) { const f32x2 v = part[(qh + 2 * j) * 32 + l31]; sum += v.x; sq += v.y; }
    const float mean = sum * (1.0f / 256.0f);
    const float rstd = rsqrtf(fmaxf(sq * (1.0f / 256.0f) - mean * mean, 0.f) + 1e-6f);
    const size_t orow = (size_t)(rowbase + l) * 1024 + h * 256 + dq * 64;
#pragma unroll
    for (int t = 0; t < 2; ++t) {
        f32x4 gwv[4]; u32x2 gtv[4];
#pragma unroll
        for (int g = 0; g < 4; ++g) { const int dv0 = t * 32 + 8 * g + 4 * hh; gwv[g] = *(const f32x4*)(p.gn + h * 256 + dq * 64 + dv0); gtv[g] = *(const u32x2*)(srg + orow + dv0); }
#pragma unroll
        for (int g = 0; g < 4; ++g) {
            const int dv0 = t * 32 + 8 * g + 4 * hh;
            const f32x4 gt = unpk4_(gtv[g]);
            f32x4 o;
#pragma unroll
            for (int j = 0; j < 4; ++j) o[j] = (acc[t][4 * g + j] - mean) * rstd * gwv[g][j] * gt[j];
            *(u32x2*)(retin + orow + dv0) = pk4(o);
        }
    }
}
DI void phase4_r3s(const Params& p, LAS unsigned char* lds) {
    for (int s = blockIdx.x; s < 32; s += gridDim.x) r3_sample_unit(p, s, lds);
}
DI void phase4_r3(const Params& p) {
    int tid = threadIdx.x; asm volatile("" : "+v"(tid));
    const int lane = tid & 63, w = __builtin_amdgcn_readfirstlane(tid >> 6), l31 = lane & 31, hh = lane >> 5;
    const bf16_t* rq = (const bf16_t*)(p.ws + OFF_RQ);
    const bf16_t* rk = (const bf16_t*)(p.ws + OFF_RK);
    const bf16_t* rvt = (const bf16_t*)(p.ws + OFF_RVT);
    const bf16_t* srg = (const bf16_t*)(p.ws + OFF_SRG);
    bf16_t* retin = (bf16_t*)(p.ws + OFF_RETIN);
    const bf16_t* kvst = (const bf16_t*)p.out;
    const bf16_t* ss = (const bf16_t*)(p.out + O_YS);
    const int nold = ((const int*)(p.ws + OFF_CTR))[40];
    for (int u = blockIdx.x; u < 256 + nold; u += gridDim.x) {
        int h, qh, rowbase; const bf16_t *stp, *vt; size_t ts;
        if (u < 256) { const int bh = u >> 5, c = (u & 31) * 4 + (w >> 1); qh = w & 1; h = bh & 3; rowbase = (bh >> 2) * 8192 + c * 64;
            stp = kvst + (size_t)(bh * 128 + c) * 32768; vt = rvt + (size_t)(bh * 128 + c) * 16384; ts = 64; }
        else { const int s = u - 256; if (w >= 2) continue; qh = w; h = s & 3; rowbase = TP + (s >> 2) * 64;
            stp = ss + (size_t)s * 32768; vt = rvt + RVT_S + (size_t)s * 16384; ts = 64; }
        const int l = qh * 32 + l31;
        const float lg = lg2gamma(h);
        const char* qbase = (const char*)(rq + (size_t)(rowbase + qh * 32) * 512 + h * 128);
        const unsigned qoff = (unsigned)(l31 * 512 + hh * 8) * 2u;
        f32x16 acc[8];
#pragma unroll
        for (int i = 0; i < 8; ++i) acc[i] = zero16();
        const unsigned soff = (unsigned)(l31 * 128 + hh * 8) * 2u;
#pragma unroll
        for (int ks = 0; ks < 8; ++ks) {
            const bf16x8 bq = *(const bf16x8*)(qbase + qoff + ks * 32);
#pragma unroll
            for (int dvt = 0; dvt < 8; ++dvt) {
                const bf16x8 a = *(const bf16x8*)((const char*)stp + soff + dvt * 8192 + ks * 32);
                acc[dvt] = MFMA32(a, bq, acc[dvt]);
            }
        }
        const float qd = fexp2((float)(l + 1) * lg);
#pragma unroll
        for (int dvt = 0; dvt < 8; ++dvt) acc[dvt] *= qd;
        const unsigned voff = (unsigned)(l31 * (unsigned)ts + hh * 8) * 2u;
        const unsigned vstep = (unsigned)ts * 64u;
        const unsigned koff = (unsigned)(pi32(l31) * 512 + hh * 8) * 2u;
        for (int kt = 0; kt <= qh; ++kt) {
            f32x16 s = zero16();
            const char* kbase = (const char*)(rk + (size_t)(rowbase + kt * 32) * 512 + h * 128);
#pragma unroll
            for (int ks = 0; ks < 8; ++ks) { const bf16x8 a = *(const bf16x8*)(kbase + koff + ks * 32); const bf16x8 bq = *(const bf16x8*)(qbase + qoff + ks * 32); s = MFMA32(a, bq, s); }
#pragma unroll
            for (int st = 0; st < 2; ++st) {
                float v[8];
#pragma unroll
                for (int j = 0; j < 8; ++j) {
                    const int reg = 8 * st + j, m = kt * 32 + pi32(crow(reg, hh)), d = l - m;
                    v[j] = d >= 0 ? s[reg] * fexp2((float)d * lg) : 0.f;
                }
                const bf16x8 P = pack8(v);
                const char* vbase = (const char*)vt + (kt * 2 + st) * 32;
#pragma unroll
                for (int dvt = 0; dvt < 8; ++dvt) {
                    const bf16x8 a = *(const bf16x8*)(vbase + voff + dvt * vstep);
                    acc[dvt] = MFMA32(a, P, acc[dvt]);
                }
            }
        }
        float sum = 0.f, sq = 0.f;
#pragma unroll
        for (int dvt = 0; dvt < 8; ++dvt)
#pragma unroll
            for (int r = 0; r < 16; ++r) { const float x = acc[dvt][r]; sum += x; sq += x * x; }
        sum = xhalf_sum(sum); sq = xhalf_sum(sq);
        const float mean = sum * (1.0f / 256.0f);
        const float rstd = rsqrtf(fmaxf(sq * (1.0f / 256.0f) - mean * mean, 0.f) + 1e-6f);
        const size_t orow = (size_t)(rowbase + l) * 1024 + h * 256;
#pragma unroll
        for (int dvt = 0; dvt < 8; ++dvt) {
            f32x4 gwv[4]; u32x2 gtv[4];
#pragma unroll
            for (int g = 0; g < 4; ++g) { const int dv0 = dvt * 32 + 8 * g + 4 * hh; gwv[g] = *(const f32x4*)(p.gn + h * 256 + dv0); gtv[g] = *(const u32x2*)(srg + orow + dv0); }
#pragma unroll
            for (int g = 0; g < 4; ++g) {
                const int dv0 = dvt * 32 + 8 * g + 4 * hh;
                const f32x4 gw = gwv[g];
                const u32x2 gt = gtv[g];
                f32x4 o;
                o[0] = (acc[dvt][4 * g + 0] - mean) * rstd * gw[0] * __uint_as_float(gt.x << 16);
                o[1] = (acc[dvt][4 * g + 1] - mean) * rstd * gw[1] * __uint_as_float(gt.x & 0xffff0000u);
                o[2] = (acc[dvt][4 * g + 2] - mean) * rstd * gw[2] * __uint_as_float(gt.y << 16);
                o[3] = (acc[dvt][4 * g + 3] - mean) * rstd * gw[3] * __uint_as_float(gt.y & 0xffff0000u);
                *(u32x2*)(retin + orow + dv0) = pk4(o);
            }
        }
    }
}

DI void epi_q(const Params& p, const f32x4 (&acc)[2][2][4][2], int pm, int tc) {
    EPI_IDS;
    bf16_t* q = (bf16_t*)(p.ws + OFF_Q);
    const float QS = 0.07216878364870322f * 1.4426950408889634f;
    const int row0 = pm * 256 + wr * 64 + fr;
    if (tc < 4) {
#pragma unroll
        for (int ai = 0; ai < 2; ++ai)
#pragma unroll
            for (int m = 0; m < 4; ++m) {
                const int row = row0 + ai * 128 + m * 16;
#pragma unroll
                for (int bj = 0; bj < 2; ++bj)
#pragma unroll
                    for (int n = 0; n < 2; ++n) {
                        const int d = wc * 32 + n * 16 + fq * 4, head = 2 * tc + bj;
                        *(u32x2*)(q + (size_t)row * 1536 + head * 192 + d) = pk4(acc[ai][bj][m][n] * QS);
                    }
            }
    } else {
#pragma unroll
        for (int ai = 0; ai < 2; ++ai)
#pragma unroll
            for (int m = 0; m < 4; ++m) {
                const int row = row0 + ai * 128 + m * 16;
                const RowInfo ri = rinfo(row);
#pragma unroll
                for (int n = 0; n < 2; ++n) {
                    const int i0 = n * 16 + fq * 4, head = 4 * (tc - 4) + wc;
                    const f32x4 x1 = acc[ai][0][m][n], x2 = acc[ai][1][m][n];
                    f32x4 o1, o2;
#pragma unroll
                    for (int j = 0; j < 4; ++j) { float c, s; rope_cs(ri.pos, 2 * (i0 + j), c, s); o1[j] = (x1[j] * c - x2[j] * s) * QS; o2[j] = (x1[j] * s + x2[j] * c) * QS; }
                    *(u32x2*)(q + (size_t)row * 1536 + head * 192 + 128 + i0) = pk4(o1);
                    *(u32x2*)(q + (size_t)row * 1536 + head * 192 + 160 + i0) = pk4(o2);
                }
            }
    }
}
DI void epi_kv(const Params& p, const f32x4 (&acc)[2][2][4][2], int pm, int tc) {
    EPI_IDS;
    bf16_t* knp = (bf16_t*)p.out;
    bf16_t* kns = (bf16_t*)(p.ws + OFF_KNS);
    const int row0 = pm * 256 + wr * 64 + fr;
#pragma unroll
    for (int ai = 0; ai < 2; ++ai)
#pragma unroll
        for (int m = 0; m < 4; ++m) {
            const int row = row0 + ai * 128 + m * 16;
            int isS, b, t;
            if (row < TP) { isS = 0; b = row >> 13; t = row & 8191; } else { const int r = row - TP; isS = 1; b = r / 2112; t = r - b * 2112; }
#pragma unroll
            for (int bj = 0; bj < 2; ++bj) {
                const int head = 2 * tc + bj;
#pragma unroll
                for (int n = 0; n < 2; ++n) {
                    const int d = wc * 32 + n * 16 + fq * 4;
                    bf16_t* dst = isS ? kns + ((size_t)(b * 8 + head) * 2112 + t) * 128 + d : knp + ((size_t)(b * 8 + head) * 8192 + t) * 128 + d;
                    *(u32x2*)dst = pk4(acc[ai][bj][m][n]);
                }
            }
        }
}
DI void epi_vT(const Params& p, const f32x4 (&acc)[2][2][4][2], int pm, int tc) {
    EPI_IDS;
    bf16_t* vtp = (bf16_t*)p.out + SZ_KNP / 2;
    bf16_t* vts = (bf16_t*)(p.ws + OFF_VTS);
#pragma unroll
    for (int bj = 0; bj < 2; ++bj)
#pragma unroll
        for (int n = 0; n < 2; ++n) {
            const int tok0 = pm * 256 + bj * 128 + wc * 32 + n * 16 + fq * 4;
#pragma unroll
            for (int ai = 0; ai < 2; ++ai) {
                const int head = 2 * (tc - 4) + ai;
                bf16_t* dst;
                if (tok0 < TP) { const int b = tok0 >> 13, t = tok0 & 8191; dst = vtp + ((size_t)(b * 8 + head) * 128 + (t >> 6)) * 8192 + (t & 63); }
                else { const int r = tok0 - TP, b = r / 2112, t = r - b * 2112; dst = vts + ((size_t)(b * 8 + head) * 33 + (t >> 6)) * 8192 + (t & 63); }
#pragma unroll
                for (int m = 0; m < 4; ++m) *(u32x2*)(dst + (wr * 64 + m * 16 + fr) * 64) = pk4(acc[ai][bj][m][n]);
            }
        }
}
struct SchedTiles {
    const bf16_t* A; const bf16_t* Bt; int lda, ldb, nM, nN, pn0, boff;
    DI bool next(int i, GUnit& u) const {
        int pm, pn; if (!tile_order((int)((blockIdx.x + boff) % gridDim.x) + i * gridDim.x, nM, nN, pm, pn)) return false;
        u.pm = pm; u.pn = pn + pn0; u.a = A + (size_t)pm * 256 * lda; u.b = Bt + (size_t)(pn + pn0) * 256 * ldb; return true;
    }
};
struct SchedKV {
    const bf16_t* X; const bf16_t* W;
    DI bool next(int i, GUnit& u) const {
        int pm, pn; if (!tile_order(blockIdx.x + i * gridDim.x, 130, 8, pm, pn)) return false;
        u.pm = pm; u.pn = pn;
        if (pn < 4) { u.a = X + (size_t)pm * 256 * 256; u.b = W + (size_t)pn * 256 * 256; }
        else { u.a = W + (size_t)pn * 256 * 256; u.b = X + (size_t)pm * 256 * 256; }
        return true;
    }
};
struct EpiKV {
    Params p;
    DI void operator()(const f32x4 (&acc)[2][2][4][2], const GUnit& u) const { if (u.pn < 4) epi_kv(p, acc, u.pm, u.pn); else epi_vT(p, acc, u.pm, u.pn); }
};
struct EpiQ {
    Params p;
    DI void operator()(const f32x4 (&acc)[2][2][4][2], const GUnit& u) const { epi_q(p, acc, u.pm, u.pn); }
};
DI void phase5_gemms(const Params& p, LAS unsigned char* shm) {
    {
        const SchedKV S{(const bf16_t*)(p.ws + OFF_CKVALL), (const bf16_t*)(p.ws + OFF_WUKV)};
        const EpiKV E{p};
        gemm_stream(shm, 256, false, 256, 4, S, E);
    }
    {
        const SchedTiles S{(const bf16_t*)(p.ws + OFF_CQ), (const bf16_t*)(p.ws + OFF_WUQ), 512, 512, 66, 6, 0, 140};
        const EpiQ E{p};
        gemm_stream(shm, 512, false, 512, 8, S, E);
    }
}

DI unsigned xb_xcc_id();
DI void phase6_attn(const Params& p, LAS unsigned char* lds, int cidx = 0) {
    int tid = threadIdx.x; asm volatile("" : "+v"(tid));
    const int lane = tid & 63, w = __builtin_amdgcn_readfirstlane(tid >> 6), l31 = lane & 31, hh = lane >> 5;
    unsigned* ctr = (unsigned*)(p.ws + OFF_CTR) + cidx;
    const bool dostore = ((const unsigned*)(p.ws + OFF_CTR))[32 + cidx] == 0u;
    bf16_t* q = (bf16_t*)(p.ws + OFF_Q);
    const bf16_t* knp = (const bf16_t*)p.out; const bf16_t* vtp = knp + SZ_KNP / 2;
    const bf16_t* kns = (const bf16_t*)(p.ws + OFF_KNS); const bf16_t* vts = (const bf16_t*)(p.ws + OFF_VTS);
    const bf16_t* kpeall = (const bf16_t*)(p.ws + OFF_KPEALL);
    constexpr int TBUF = 40960, KPO = 16384, VO = 24576, UOFF = 3 * TBUF;
    unsigned* qctr = (unsigned*)(p.ws + OFF_CTR) + 48;
    const int myx = (int)(xb_xcc_id() & 7u);
    int steal = 0;
    for (;;) {
        if (tid == 0) {
            unsigned enc = 0xffffffffu;
            while (steal < 8) {
                const int qx = (myx + steal) & 7;
                const unsigned v = atomicAdd(qctr + qx, 1u);
                if (v < 72u) { enc = (unsigned)qx * 128u + v; break; }
                ++steal;
            }
            *(LAS unsigned*)(lds + UOFF) = enc;
        }
        __syncthreads();
        const unsigned enc = *(LAS unsigned*)(lds + UOFF);
        __syncthreads();
        if (enc == 0xffffffffu) break;
        const int qx = (int)(enc >> 7), v = (int)(enc & 127u);
        int uu;
        if (v < 46) uu = (v >> 1) * 16 + 2 * qx + (v & 1);
        else if (v < 54) uu = 512 + qx * 8 + (v - 46);
        else uu = ((v - 8) >> 1) * 16 + 2 * qx + ((v - 8) & 1);
        int h, rowq0, nkt, limit; bool active; const bf16_t *kn, *kpe, *vt;
        if (uu < 512) { const int qb = 31 - (uu >> 4), bh = uu & 15, b = bh >> 3; h = bh & 7; rowq0 = b * 8192 + qb * 256; nkt = 4 * qb + 4; limit = 4 * qb + (w >> 1); active = true;
            kn = knp + (size_t)bh * 8192 * 128; kpe = kpeall + (size_t)b * 8192 * 64; vt = vtp + (size_t)bh * 128 * 8192; }
        else { const int su = uu - 512, b = su >> 3; h = su & 7; rowq0 = TP + b * 64; nkt = 33; limit = 32; active = w < 2;
            kn = kns + (size_t)su * 2112 * 128; kpe = kpeall + (size_t)(TP + b * 2112) * 64; vt = vts + (size_t)su * 33 * 8192; }
        bf16x8 Bq[12];
        bf16_t* qrow = q + (size_t)(rowq0 + 32 * w + l31) * 1536 + h * 192;
        if (active) {
#pragma unroll
            for (int ks = 0; ks < 12; ++ks) Bq[ks] = *(const bf16x8*)(qrow + ks * 16 + hh * 8);
        } else {
#pragma unroll
            for (int ks = 0; ks < 12; ++ks) Bq[ks] = (bf16x8){0, 0, 0, 0, 0, 0, 0, 0};
        }
        f32x16 o[4];
#pragma unroll
        for (int i = 0; i < 4; ++i) o[i] = zero16();
        float mrun = -INFINITY, lsum = 0.f;
        unsigned gk[2], gp, gv[2];
#pragma unroll
        for (int i = 0; i < 2; ++i) {
            const int rowk = 4 * (2 * w + i) + (lane >> 4), sl = lane & 15;
            gk[i] = (unsigned)(rowk * 128 + ((sl ^ (rowk & 15)) * 8));
            const int rowv = 8 * (2 * w + i) + (lane >> 3), sv = lane & 7;
            gv[i] = (unsigned)(rowv * 64 + ((sv ^ ((rowv >> 1) & 7)) * 8));
        }
        { const int rowp = 8 * w + (lane >> 3), sp = lane & 7; gp = (unsigned)(rowp * 64 + ((sp ^ ((rowp >> 1) & 7)) * 8)); }
#define ATT_GLDS(boff, kt) do { \
            __builtin_amdgcn_global_load_lds((const unsigned*)(kn + (size_t)(kt) * 8192 + gk[0]), (LAS unsigned*)(lds + (boff) + (2 * w) * 1024), 16, 0, 0); \
            __builtin_amdgcn_global_load_lds((const unsigned*)(kn + (size_t)(kt) * 8192 + gk[1]), (LAS unsigned*)(lds + (boff) + (2 * w + 1) * 1024), 16, 0, 0); \
            __builtin_amdgcn_global_load_lds((const unsigned*)(kpe + (size_t)(kt) * 4096 + gp), (LAS unsigned*)(lds + (boff) + KPO + w * 1024), 16, 0, 0); \
            __builtin_amdgcn_global_load_lds((const unsigned*)(vt + (size_t)(kt) * 8192 + gv[0]), (LAS unsigned*)(lds + (boff) + VO + (2 * w) * 1024), 16, 0, 0); \
            __builtin_amdgcn_global_load_lds((const unsigned*)(vt + (size_t)(kt) * 8192 + gv[1]), (LAS unsigned*)(lds + (boff) + VO + (2 * w + 1) * 1024), 16, 0, 0); } while (0)
        const int krow = pi32(l31);
        unsigned ka[12], va[4];
#pragma unroll
        for (int ks = 0; ks < 8; ++ks) ka[ks] = (unsigned)(krow * 256 + (((ks * 2 + hh) ^ (krow & 15)) * 16));
#pragma unroll
        for (int ks = 8; ks < 12; ++ks) ka[ks] = (unsigned)(KPO + krow * 128 + ((((ks - 8) * 2 + hh) ^ ((krow >> 1) & 7)) * 16));
#pragma unroll
        for (int kk = 0; kk < 4; ++kk) va[kk] = (unsigned)(VO + l31 * 128 + (((kk * 2 + hh) ^ ((l31 >> 1) & 7)) * 16));
        ATT_GLDS(0, 0);
        if (nkt > 1) { ATT_GLDS(TBUF, 1); asm volatile("s_waitcnt vmcnt(5)" ::: "memory"); }
        else asm volatile("s_waitcnt vmcnt(0)" ::: "memory");
        __syncthreads();
        int boff = 0, bnn = 2 * TBUF;
        for (int kt = 0; kt < nkt; ++kt) {
            const bool more = kt + 2 < nkt;
            if (more) ATT_GLDS(bnn, kt + 2);
            if (active && kt <= limit) {
                const LAS unsigned char* tb = lds + boff;
#define KFR(sub, ks) (*(const LAS bf16x8*)(tb + ka[ks] + (sub) * 32 * ((ks) < 8 ? 256 : 128)))
#define VFR(f) (*(const LAS bf16x8*)(tb + va[(f) & 3] + ((f) >> 2) * 32 * 128))
#define SBAR __builtin_amdgcn_sched_barrier(0)
                bf16x8 fa[4], fb[4];
                f32x16 s[2]; s[0] = zero16(); s[1] = zero16();
#pragma unroll
                for (int i = 0; i < 4; ++i) fa[i] = KFR(0, i);
                SBAR;
#pragma unroll
                for (int i = 0; i < 4; ++i) { fb[i] = KFR(0, 4 + i); s[0] = MFMA32(fa[i], Bq[i], s[0]); }
                SBAR;
#pragma unroll
                for (int i = 0; i < 4; ++i) { fa[i] = KFR(0, 8 + i); s[0] = MFMA32(fb[i], Bq[4 + i], s[0]); }
                SBAR;
#pragma unroll
                for (int i = 0; i < 4; ++i) { fb[i] = KFR(1, i); s[0] = MFMA32(fa[i], Bq[8 + i], s[0]); }
                SBAR;
#pragma unroll
                for (int i = 0; i < 4; ++i) { fa[i] = KFR(1, 4 + i); s[1] = MFMA32(fb[i], Bq[i], s[1]); }
                SBAR;
#pragma unroll
                for (int i = 0; i < 4; ++i) { fb[i] = KFR(1, 8 + i); s[1] = MFMA32(fa[i], Bq[4 + i], s[1]); }
                SBAR;
#pragma unroll
                for (int i = 0; i < 4; ++i) { fa[i] = VFR(i); s[1] = MFMA32(fb[i], Bq[8 + i], s[1]); }
                SBAR;
                float mx = s[0][0];
#pragma unroll
                for (int r = 0; r < 16; ++r) { mx = fmaxf(mx, s[0][r]); mx = fmaxf(mx, s[1][r]); }
                mx = xhalf_max(mx);
                if (__builtin_amdgcn_ballot_w64(mx > mrun + 8.0f) != 0ull) {
                    const float mnew = mx > mrun + 8.0f ? mx : mrun;
                    const float alpha = fexp2(mrun - mnew);
                    mrun = mnew;
                    lsum *= alpha;
#pragma unroll
                    for (int dvt = 0; dvt < 4; ++dvt) o[dvt] *= alpha;
                }
                const float mnew = mrun;
                float ps = 0.f;
                bf16x8 P[4];
#pragma unroll
                for (int i = 0; i < 4; ++i) fb[i] = VFR(4 + i);
#pragma unroll
                for (int sub = 0; sub < 2; ++sub)
#pragma unroll
                    for (int st = 0; st < 2; ++st) {
                        float v[8];
#pragma unroll
                        for (int j = 0; j < 8; ++j) { v[j] = fexp2(s[sub][8 * st + j] - mnew); ps += v[j]; }
                        P[sub * 2 + st] = pack8(v);
                    }
                lsum += ps;
                SBAR;
#pragma unroll
                for (int i = 0; i < 4; ++i) o[0] = MFMA32(fa[i], P[i], o[0]);
                SBAR;
#pragma unroll
                for (int i = 0; i < 4; ++i) { fa[i] = VFR(8 + i); o[1] = MFMA32(fb[i], P[i], o[1]); }
                SBAR;
#pragma unroll
                for (int i = 0; i < 4; ++i) { fb[i] = VFR(12 + i); o[2] = MFMA32(fa[i], P[i], o[2]); }
                SBAR;
#pragma unroll
                for (int i = 0; i < 4; ++i) o[3] = MFMA32(fb[i], P[i], o[3]);
            }
            if (more) asm volatile("s_waitcnt vmcnt(5)" ::: "memory"); else asm volatile("s_waitcnt vmcnt(0)" ::: "memory");
            __syncthreads();
            { const int nb = boff + TBUF >= 3 * TBUF ? 0 : boff + TBUF; bnn = boff; boff = nb; }
        }
        if (active && dostore) {
            const float ltot = xhalf_sum(lsum);
            const float inv = 1.0f / ltot;
#pragma unroll
            for (int dvt = 0; dvt < 4; ++dvt)
#pragma unroll
                for (int g4 = 0; g4 < 4; ++g4) {
                    f32x4 v; v[0] = o[dvt][4 * g4] * inv; v[1] = o[dvt][4 * g4 + 1] * inv; v[2] = o[dvt][4 * g4 + 2] * inv; v[3] = o[dvt][4 * g4 + 3] * inv;
                    *(u32x2*)(qrow + dvt * 32 + 8 * g4 + 4 * hh) = pk4(v);
                }
        }
    }
}

template <int PASS>
DI void phase8_pass(const Params& p, LAS unsigned char* shm) {
    const bf16_t* sg = (const bf16_t*)(p.ws + (PASS == 0 ? OFF_SGA : OFF_SGB));
    bf16_t* merged = (bf16_t*)(p.ws + OFF_MERGED);
    for (int L = blockIdx.x;; L += gridDim.x) {
        int pm, pn; if (!tile_order(L, 64, 4, pm, pn)) break;
        f32x4 acc[2][2][4][2]; ZERO_ACC(acc);
        if (PASS == 0) gemm_kloop(acc, (const bf16_t*)(p.ws + OFF_RETIN), 1024, false, (const bf16_t*)(p.ws + OFF_WRO), 1024, 16, pm * 256, pn * 256, shm);
        else gemm_kloop(acc, (const bf16_t*)(p.ws + OFF_Q), 1536, true, (const bf16_t*)(p.ws + OFF_WMO), 1024, 16, pm * 256, pn * 256, shm);
        EPI_IDS;
        const int row0 = pm * 256 + wr * 64 + fr;
#pragma unroll
        for (int ai = 0; ai < 2; ++ai)
#pragma unroll
            for (int mp = 0; mp < 2; ++mp) {
                u32x2 gb[2][2][2], tb[2][2][2];
#pragma unroll
                for (int mm = 0; mm < 2; ++mm) {
                    const size_t rbase = (size_t)(row0 + ai * 128 + (mp * 2 + mm) * 16) * 1024 + pn * 256 + wc * 32 + fq * 4;
#pragma unroll
                    for (int bj = 0; bj < 2; ++bj)
#pragma unroll
                        for (int n = 0; n < 2; ++n) {
                            gb[mm][bj][n] = *(const u32x2*)(sg + rbase + bj * 128 + n * 16);
                            if (PASS == 1) tb[mm][bj][n] = *(const u32x2*)(merged + rbase + bj * 128 + n * 16);
                        }
                }
#pragma unroll
                for (int mm = 0; mm < 2; ++mm) {
                    const int m = mp * 2 + mm;
                    const size_t rbase = (size_t)(row0 + ai * 128 + m * 16) * 1024 + pn * 256 + wc * 32 + fq * 4;
#pragma unroll
                    for (int bj = 0; bj < 2; ++bj)
#pragma unroll
                        for (int n = 0; n < 2; ++n) {
                            const u32x2 b = gb[mm][bj][n];
                            f32x4 r; r[0] = __uint_as_float(b.x << 16); r[1] = __uint_as_float(b.x & 0xffff0000u); r[2] = __uint_as_float(b.y << 16); r[3] = __uint_as_float(b.y & 0xffff0000u);
                            f32x4 o = acc[ai][bj][m][n] * r;
                            if (PASS == 1) {
                                const u32x2 t = tb[mm][bj][n];
                                o[0] += __uint_as_float(t.x << 16); o[1] += __uint_as_float(t.x & 0xffff0000u); o[2] += __uint_as_float(t.y << 16); o[3] += __uint_as_float(t.y & 0xffff0000u);
                            }
                            *(u32x2*)(merged + rbase + bj * 128 + n * 16) = pk4(o);
                        }
                }
            }
    }
}
DI void phase8_merge(const Params& p, LAS unsigned char* shm) { phase8_pass<0>(p, shm); phase8_pass<1>(p, shm); }
DI float* hrow(const Params& p, int row) { return row < TP ? p.out + O_YP + (size_t)row * 1024 : p.out + O_YS + (size_t)(row - TP) * 1024; }
DI void phase9_out(const Params& p, LAS unsigned char* shm) {
    for (int L = blockIdx.x;; L += gridDim.x) {
        int pm, pn; if (!tile_order(L, 64, 4, pm, pn)) break;
        f32x4 acc[2][2][4][2]; ZERO_ACC(acc);
        gemm_kloop(acc, (const bf16_t*)(p.ws + OFF_MERGED), 1024, false, (const bf16_t*)(p.ws + OFF_WOUT), 1024, 16, pm * 256, pn * 256, shm);
        EPI_IDS;
        const int row0 = pm * 256 + wr * 64 + fr;
        const int cb = pn * 256 + wc * 32 + fq * 4;
        f32x4 gv[2][2];
#pragma unroll
        for (int bj = 0; bj < 2; ++bj)
#pragma unroll
            for (int n = 0; n < 2; ++n) gv[bj][n] = *(const f32x4*)(p.nffn + cb + bj * 128 + n * 16);
#pragma unroll
        for (int ai = 0; ai < 2; ++ai)
#pragma unroll
            for (int mp = 0; mp < 2; ++mp) {
                f32x4 xv[2][2][2];
#pragma unroll
                for (int mm = 0; mm < 2; ++mm) {
                    const int row = row0 + ai * 128 + (mp * 2 + mm) * 16;
                    const float* xr = row < TP ? p.x_p + (size_t)row * 1024 : p.x_s + (size_t)(row - TP) * 1024;
#pragma unroll
                    for (int bj = 0; bj < 2; ++bj)
#pragma unroll
                        for (int n = 0; n < 2; ++n) xv[mm][bj][n] = *(const f32x4*)(xr + cb + bj * 128 + n * 16);
                }
#pragma unroll
                for (int mm = 0; mm < 2; ++mm) {
                    const int m = mp * 2 + mm, row = row0 + ai * 128 + m * 16;
                    float* hr = hrow(p, row);
                    bf16_t* hb = (bf16_t*)(p.ws + OFF_HN) + (size_t)row * 1024;
                    float ss = 0.f;
#pragma unroll
                    for (int bj = 0; bj < 2; ++bj)
#pragma unroll
                        for (int n = 0; n < 2; ++n) {
                            const int c = cb + bj * 128 + n * 16;
                            const f32x4 hv = xv[mm][bj][n] + acc[ai][bj][m][n];
                            *(f32x4*)(hr + c) = hv;
                            *(u32x2*)(hb + c) = pk4(hv * gv[bj][n]);
                            ss += hv[0] * hv[0] + hv[1] * hv[1] + hv[2] * hv[2] + hv[3] * hv[3];
                        }
                    ss += __shfl_xor(ss, 16); ss += __shfl_xor(ss, 32);
                    if (fq == 0) atomicAdd((float*)(p.ws + OFF_ROWSS) + row, ss);
                }
            }
    }
}
DI void phase10_hn(const Params& p) {
    const int gtid = blockIdx.x * NTHREADS + threadIdx.x, nth = gridDim.x * NTHREADS;
    const int gw = gtid >> 6, nw = nth >> 6, lane = threadIdx.x & 63;
    bf16_t* hn = (bf16_t*)(p.ws + OFF_HN);
    for (int row = gw; row < TALL; row += 2 * nw) {
        const int row2 = row + nw;
        if (row2 < TALL) rmsnorm_row2_1024(hrow(p, row), hrow(p, row2), p.nffn, hn + (size_t)row * 1024, hn + (size_t)row2 * 1024, lane);
        else rmsnorm_row_1024(hrow(p, row), p.nffn, hn + (size_t)row * 1024, lane);
    }
}
struct EpiGU {
    Params p;
    DI void operator()(const f32x4 (&acc)[2][2][4][2], const GUnit& u) const {
        EPI_IDS;
        bf16_t* act = (bf16_t*)(p.ws + OFF_ACT);
        const int row0 = u.pm * 256 + wr * 64 + fr;
        float rss[2][4];
#pragma unroll
        for (int ai = 0; ai < 2; ++ai)
#pragma unroll
            for (int m = 0; m < 4; ++m) rss[ai][m] = ((const float*)(p.ws + OFF_ROWSS))[row0 + ai * 128 + m * 16];
#pragma unroll
        for (int ai = 0; ai < 2; ++ai)
#pragma unroll
            for (int m = 0; m < 4; ++m) {
                const float rstd = rsqrtf(rss[ai][m] * (1.0f / 1024.0f) + 1e-6f);
#pragma unroll
                for (int n = 0; n < 2; ++n) {
                    const f32x4 g = acc[ai][0][m][n] * rstd, uu = acc[ai][1][m][n] * rstd;
                    f32x4 o;
#pragma unroll
                    for (int j = 0; j < 4; ++j) o[j] = siluf_(g[j]) * uu[j];
                    *(u32x2*)(act + (size_t)(row0 + ai * 128 + m * 16) * 2816 + u.pn * 128 + wc * 32 + n * 16 + fq * 4) = pk4(o);
                }
            }
    }
};
DI void phase11_gu(const Params& p, LAS unsigned char* shm) {
    const SchedTiles S{(const bf16_t*)(p.ws + OFF_HN), (const bf16_t*)(p.ws + OFF_WGU), 1024, 1024, 66, 22, 0, 0};
    const EpiGU E{p};
    gemm_stream(shm, 1024, false, 1024, 16, S, E);
}
DI unsigned xb_ld(unsigned* p);
DI unsigned xb_add(unsigned* p, unsigned v);
DI void phase12_down(const Params& p, LAS unsigned char* shm, bool fused) {
    for (int L = blockIdx.x;; L += gridDim.x) {
        int pm, pn; if (!tile_order(L, 64, 4, pm, pn)) break;
        f32x4 acc[2][2][4][2]; ZERO_ACC(acc);
        gemm_kloop(acc, (const bf16_t*)(p.ws + OFF_ACT), 2816, false, (const bf16_t*)(p.ws + OFF_WDN), 2816, 44, pm * 256, pn * 256, shm);
        EPI_IDS;
        const int tid = wid * 64 + lane;
        const int row0 = pm * 256 + wr * 64 + fr;
        const int cb = pn * 256 + wc * 32 + fq * 4;
        float ssr[2][4];
#pragma unroll
        for (int ai = 0; ai < 2; ++ai)
#pragma unroll
            for (int mp = 0; mp < 2; ++mp) {
                f32x4 hv[2][2][2];
#pragma unroll
                for (int mm = 0; mm < 2; ++mm) {
                    const float* hr = hrow(p, row0 + ai * 128 + (mp * 2 + mm) * 16);
#pragma unroll
                    for (int bj = 0; bj < 2; ++bj)
#pragma unroll
                        for (int n = 0; n < 2; ++n) hv[mm][bj][n] = *(const f32x4*)(hr + cb + bj * 128 + n * 16);
                }
#pragma unroll
                for (int mm = 0; mm < 2; ++mm) {
                    const int m = mp * 2 + mm;
                    float ss = 0.f;
#pragma unroll
                    for (int bj = 0; bj < 2; ++bj)
#pragma unroll
                        for (int n = 0; n < 2; ++n) {
                            const f32x4 v = hv[mm][bj][n] + acc[ai][bj][m][n];
                            acc[ai][bj][m][n] = v;
                            ss += v[0] * v[0] + v[1] * v[1] + v[2] * v[2] + v[3] * v[3];
                        }
                    ss += __shfl_xor(ss, 16); ss += __shfl_xor(ss, 32);
                    ssr[ai][m] = ss;
                }
            }
        if (!fused) {
#pragma unroll
            for (int ai = 0; ai < 2; ++ai)
#pragma unroll
                for (int m = 0; m < 4; ++m) {
                    float* hr = hrow(p, row0 + ai * 128 + m * 16);
#pragma unroll
                    for (int bj = 0; bj < 2; ++bj)
#pragma unroll
                        for (int n = 0; n < 2; ++n) *(f32x4*)(hr + cb + bj * 128 + n * 16) = acc[ai][bj][m][n];
                }
            continue;
        }
        LAS float* part = (LAS float*)shm;
        LAS float* rst = part + 1024;
        __syncthreads();
        if (fq == 0) {
#pragma unroll
            for (int ai = 0; ai < 2; ++ai)
#pragma unroll
                for (int m = 0; m < 4; ++m) part[wc * 256 + ai * 128 + wr * 64 + m * 16 + fr] = ssr[ai][m];
        }
        __syncthreads();
        float* xbuf = (float*)(p.ws + OFF_XBUF) + (size_t)pm * 1024;
        unsigned* cnt = (unsigned*)(p.ws + OFF_PCNT) + pm * 64;
        if (tid < 256) __hip_atomic_store(xbuf + pn * 256 + tid, part[tid] + part[256 + tid] + part[512 + tid] + part[768 + tid], __ATOMIC_RELAXED, __HIP_MEMORY_SCOPE_AGENT);
        __builtin_amdgcn_fence(__ATOMIC_RELEASE, "agent");
        asm volatile("s_waitcnt vmcnt(0)" ::: "memory");
        __syncthreads();
        if (tid == 0) {
            xb_add(cnt, 1u);
            unsigned sp = 0;
            while (xb_ld(cnt) < 4u) { __builtin_amdgcn_s_sleep(1); if (++sp > (1u << 22)) break; }
            __builtin_amdgcn_fence(__ATOMIC_ACQUIRE, "agent");
            asm volatile("s_waitcnt vmcnt(0)" ::: "memory");
        }
        __syncthreads();
        if (tid < 256) {
            float s = 0.f;
#pragma unroll
            for (int q = 0; q < 4; ++q) s += __hip_atomic_load(xbuf + q * 256 + tid, __ATOMIC_RELAXED, __HIP_MEMORY_SCOPE_AGENT);
            rst[tid] = rsqrtf(s * (1.0f / 1024.0f) + 1e-6f);
        }
        __syncthreads();
        f32x4 gv[2][2];
#pragma unroll
        for (int bj = 0; bj < 2; ++bj)
#pragma unroll
            for (int n = 0; n < 2; ++n) gv[bj][n] = *(const f32x4*)(p.nfin + cb + bj * 128 + n * 16);
#pragma unroll
        for (int ai = 0; ai < 2; ++ai)
#pragma unroll
            for (int m = 0; m < 4; ++m) {
                const float rs = rst[ai * 128 + wr * 64 + m * 16 + fr];
                float* yr = hrow(p, row0 + ai * 128 + m * 16);
#pragma unroll
                for (int bj = 0; bj < 2; ++bj)
#pragma unroll
                    for (int n = 0; n < 2; ++n) *(f32x4*)(yr + cb + bj * 128 + n * 16) = acc[ai][bj][m][n] * rs * gv[bj][n];
            }
    }
}
DI void phase13_final(const Params& p, int rowstart) {
    const int gtid = blockIdx.x * NTHREADS + threadIdx.x, nth = gridDim.x * NTHREADS;
    const int gw = gtid >> 6, nw = nth >> 6, lane = threadIdx.x & 63;
    for (int row = rowstart + gw; row < TALL; row += nw) {
        float* x = hrow(p, row);
        f32x4 v[4]; float ss = 0.f;
#pragma unroll
        for (int i = 0; i < 4; ++i) { v[i] = *(const f32x4*)(x + i * 256 + lane * 4); ss += v[i][0] * v[i][0] + v[i][1] * v[i][1] + v[i][2] * v[i][2] + v[i][3] * v[i][3]; }
        ss = wave_sum(ss);
        const float rstd = rsqrtf(ss * (1.0f / 1024.0f) + 1e-6f);
#pragma unroll
        for (int i = 0; i < 4; ++i) { const f32x4 gg = *(const f32x4*)(p.nfin + i * 256 + lane * 4); *(f32x4*)(x + i * 256 + lane * 4) = v[i] * rstd * gg; }
    }
}

DI f32x4 thin_block(const bf16_t* __restrict__ A, int lda, bool a192, const bf16_t* __restrict__ Bt, int ldb, int K, int row0, int col0, LAS unsigned char* lds) {
    int tid = threadIdx.x; asm volatile("" : "+v"(tid));
    const int lane = tid & 63, w = __builtin_amdgcn_readfirstlane(tid >> 6), l31 = lane & 31, hh = lane >> 5;
    const int kw = K >> 3;
    const int kb = w * kw, ka = a192 ? w * 192 : kb;
    const bf16_t* ap = A + (size_t)(row0 + l31) * lda + ka + hh * 8;
    const bf16_t* bp = Bt + (size_t)(col0 + l31) * ldb + kb + hh * 8;
    f32x16 acc0 = zero16(), acc1 = zero16();
    for (int k = 0; k < kw; k += 64) {
        bf16x8 a[4], b0[4], b1[4];
#pragma unroll
        for (int i = 0; i < 4; ++i) {
            const int kk = k + 16 * i;
            const bool ok = kk < kw;
            a[i] = ok ? *(const bf16x8*)(ap + kk) : (bf16x8){0, 0, 0, 0, 0, 0, 0, 0};
            b0[i] = ok ? *(const bf16x8*)(bp + kk) : (bf16x8){0, 0, 0, 0, 0, 0, 0, 0};
            b1[i] = ok ? *(const bf16x8*)(bp + (size_t)32 * ldb + kk) : (bf16x8){0, 0, 0, 0, 0, 0, 0, 0};
        }
#pragma unroll
        for (int i = 0; i < 4; ++i) { acc0 = MFMA32(a[i], b0[i], acc0); acc1 = MFMA32(a[i], b1[i], acc1); }
    }
    __syncthreads();
    LAS float* part = (LAS float*)lds;
#pragma unroll
    for (int r = 0; r < 16; ++r) {
        const int row = crow(r, hh);
        part[(w * 32 + row) * 64 + l31] = acc0[r];
        part[(w * 32 + row) * 64 + 32 + l31] = acc1[r];
    }
    __syncthreads();
    f32x4 o = {0.f, 0.f, 0.f, 0.f};
#pragma unroll
    for (int ww = 0; ww < 8; ++ww) o += *(const LAS f32x4*)(part + (ww * 32 + (tid >> 4)) * 64 + (tid & 15) * 4);
    return o;
}
template <int WHICH>
DI void thin_phase(const Params& p, LAS unsigned char* lds) {
    const int ncb = WHICH == 7 ? 32 : 16;
    for (int t = blockIdx.x; t < 16 * ncb; t += gridDim.x) {
        const int rbk = t & 15, cbk = t >> 4;
        const int row0 = TP + rbk * 32, col0 = cbk * 64;
        int tid = threadIdx.x; asm volatile("" : "+v"(tid));
        const int row = row0 + (tid >> 4), c = col0 + (tid & 15) * 4;
        if (WHICH == 7) {
            const f32x4 acc = thin_block((const bf16_t*)(p.ws + OFF_XN), 1024, false, (const bf16_t*)(p.ws + OFF_WIN) + (size_t)4096 * 1024, 1024, 1024, row0, col0, lds);
            bf16_t* dst = (bf16_t*)(p.ws + (c < 1024 ? OFF_SGA : OFF_SGB)) + (size_t)row * 1024 + (c & 1023);
            f32x4 v; for (int j = 0; j < 4; ++j) v[j] = sigmoidf_(acc[j]);
            *(u32x2*)dst = pk4(v);
        } else if (WHICH == 8) {
            const f32x4 a1 = thin_block((const bf16_t*)(p.ws + OFF_RETIN), 1024, false, (const bf16_t*)(p.ws + OFF_WRO), 1024, 1024, row0, col0, lds);
            const f32x4 a2 = thin_block((const bf16_t*)(p.ws + OFF_Q), 1536, true, (const bf16_t*)(p.ws + OFF_WMO), 1024, 1024, row0, col0, lds);
            const size_t idx = (size_t)row * 1024 + c;
            const u32x2 ga = *(const u32x2*)((const bf16_t*)(p.ws + OFF_SGA) + idx), gb = *(const u32x2*)((const bf16_t*)(p.ws + OFF_SGB) + idx);
            f32x4 o;
            o[0] = __uint_as_float(ga.x << 16) * a1[0] + __uint_as_float(gb.x << 16) * a2[0];
            o[1] = __uint_as_float(ga.x & 0xffff0000u) * a1[1] + __uint_as_float(gb.x & 0xffff0000u) * a2[1];
            o[2] = __uint_as_float(ga.y << 16) * a1[2] + __uint_as_float(gb.y << 16) * a2[2];
            o[3] = __uint_as_float(ga.y & 0xffff0000u) * a1[3] + __uint_as_float(gb.y & 0xffff0000u) * a2[3];
            *(u32x2*)((bf16_t*)(p.ws + OFF_MERGED) + idx) = pk4(o);
        } else if (WHICH == 9) {
            const f32x4 acc = thin_block((const bf16_t*)(p.ws + OFF_MERGED), 1024, false, (const bf16_t*)(p.ws + OFF_WOUT), 1024, 1024, row0, col0, lds);
            const size_t o = (size_t)(row - TP) * 1024 + c;
            const f32x4 hv = *(const f32x4*)(p.x_s + o) + acc;
            *(f32x4*)(p.out + O_YS + o) = hv;
            *(u32x2*)((bf16_t*)(p.ws + OFF_HN) + (size_t)row * 1024 + c) = pk4(hv * *(const f32x4*)(p.nffn + c));
            float ss = hv[0] * hv[0] + hv[1] * hv[1] + hv[2] * hv[2] + hv[3] * hv[3];
            ss += __shfl_xor(ss, 1); ss += __shfl_xor(ss, 2); ss += __shfl_xor(ss, 4); ss += __shfl_xor(ss, 8);
            if ((tid & 15) == 0) atomicAdd((float*)(p.ws + OFF_ROWSS) + row, ss);
        } else {
            const f32x4 acc = thin_block((const bf16_t*)(p.ws + OFF_ACT), 2816, false, (const bf16_t*)(p.ws + OFF_WDN), 2816, 2816, row0, col0, lds);
            float* hp = p.out + O_YS + (size_t)(row - TP) * 1024 + c;
            *(f32x4*)hp = *(const f32x4*)hp + acc;
        }
    }
}

#define XB_TMO      128
#define XB_XCNT(j)  (256  + 64 * (j))
#define XB_XSUB(j)  (1280 + 64 * (j))
#define XB_XGEN(j)  (2304 + 64 * (j))
#define XB_TOP      3328
#define XB_TOPGEN   3392
#define XCD_BAR_WORDS 3456
#define XB_SPIN_CAP (1u << 18)
DI unsigned xb_ld(unsigned* p) { return __hip_atomic_load(p, __ATOMIC_RELAXED, __HIP_MEMORY_SCOPE_AGENT); }
DI unsigned xb_add(unsigned* p, unsigned v) { return __hip_atomic_fetch_add(p, v, __ATOMIC_RELAXED, __HIP_MEMORY_SCOPE_AGENT); }
DI unsigned xb_xcc_id() { return (unsigned)__builtin_amdgcn_s_getreg((3 << 11) | 20) & 0xFu; }
#define XB_SPIN(cond, bar) do { unsigned _sp = 0; while (cond) { __builtin_amdgcn_s_sleep(1); \
    if ((++_sp & 255u) == 0u) { if (xb_ld(&(bar)[XB_TMO])) break; if (_sp > XB_SPIN_CAP) { atomicAdd(&(bar)[XB_TMO], 1u); break; } } } } while (0)
struct XcdBarrier { unsigned* bar; unsigned x; volatile LAS unsigned* st; };
DI XcdBarrier xcd_barrier_post(unsigned* bar, volatile LAS unsigned* st) {
    XcdBarrier b; b.bar = bar; b.x = xb_xcc_id(); b.st = st;
    if (threadIdx.x == 0) (void)xb_add(&bar[XB_XCNT(b.x)], 1u);
    return b;
}
DI void xcd_barrier_complete(unsigned* bar, unsigned x, unsigned& nloc, unsigned& nx) {
    const unsigned G = gridDim.x * gridDim.y * gridDim.z;
    unsigned sum, cnt, mine, sp = 0u;
    for (;;) {
        sum = 0u; cnt = 0u; mine = 0u;
#pragma unroll
        for (unsigned j = 0; j < 16; ++j) { const unsigned c = xb_ld(&bar[XB_XCNT(j)]); sum += c; cnt += (c > 0u) ? 1u : 0u; mine = (j == x) ? c : mine; }
        if (sum == G) break;
        __builtin_amdgcn_s_sleep(1);
        if ((++sp & 255u) == 0u) { if (xb_ld(&bar[XB_TMO])) break; if (sp > XB_SPIN_CAP) { atomicAdd(&bar[XB_TMO], 1u); break; } }
    }
    nloc = mine > 0u ? mine : 1u; nx = cnt > 0u ? cnt : 1u;
}
DI void xcd_barrier(const XcdBarrier& b) {
    asm volatile("s_waitcnt vmcnt(0)" ::: "memory");
    __syncthreads();
    if (threadIdx.x == 0) {
        unsigned* bar = b.bar;
        __builtin_amdgcn_s_waitcnt(0);
        unsigned nloc = b.st[0], nx = b.st[1];
        if (nloc == 0u) { xcd_barrier_complete(bar, b.x, nloc, nx); b.st[0] = nloc; b.st[1] = nx; }
        const unsigned old = xb_add(&bar[XB_XSUB(b.x)], 1u);
        const unsigned gen = old / nloc;
        if (old + 1u == (gen + 1u) * nloc) {
            __builtin_amdgcn_fence(__ATOMIC_RELEASE, "agent");
            asm volatile("s_waitcnt vmcnt(0)" ::: "memory");
            const unsigned og = xb_add(&bar[XB_TOP], 1u);
            const unsigned tg = og / nx;
            if (og + 1u == (tg + 1u) * nx) xb_add(&bar[XB_TOPGEN], 1u);
            else XB_SPIN(xb_ld(&bar[XB_TOPGEN]) == tg, bar);
            __builtin_amdgcn_fence(__ATOMIC_ACQUIRE, "agent");
            xb_add(&bar[XB_XGEN(b.x)], 1u);
            asm volatile("s_waitcnt vmcnt(0)" ::: "memory");
        } else {
            XB_SPIN(xb_ld(&bar[XB_XGEN(b.x)]) == gen, bar);
            __builtin_amdgcn_fence(__ATOMIC_ACQUIRE, "agent");
            asm volatile("s_waitcnt vmcnt(0)" ::: "memory");
        }
    }
    __syncthreads();
}

__global__ void __launch_bounds__(NTHREADS) fwd_megakernel(Params p) {
    extern __shared__ __attribute__((aligned(16))) unsigned char smem[];
    cg::grid_group grid = cg::this_grid();
    LAS unsigned char* shm = (LAS unsigned char*)smem;
#ifndef PMASK
#define PMASK 0xffff
#endif
#define PH(k) if ((PMASK >> (k)) & 1)
    volatile LAS unsigned* xst = (volatile LAS unsigned*)(shm + 131072);
    if (threadIdx.x == 0) { xst[0] = 0u; xst[1] = 0u; }
    __syncthreads();
    const XcdBarrier xbar = xcd_barrier_post((unsigned*)(p.ws + OFF_BAR), xst);
    if (p.ws == nullptr) grid.sync();
#define GSYNC() xcd_barrier(xbar)
#ifdef TIMING_RUN
    unsigned long long* tsb = (unsigned long long*)(p.ws + OFF_CTR + 256);
    int tsi = 0;
#define STAMP() do { if (blockIdx.x == 0 && threadIdx.x == 0) tsb[tsi] = wall_clock64(); ++tsi; } while (0)
#else
#define STAMP() do {} while (0)
#endif
    STAMP();
    PH(0) phase0(p, shm);
#if PROBE_DOUBLE == 100
    phase0(p, shm);
#endif
    GSYNC(); STAMP();
    PH(1) phase1_gemm(p, shm);
#if PROBE_DOUBLE == 1
    phase1_gemm(p, shm);
#endif
    GSYNC(); STAMP();
    PH(2) { phase2_elem(p); phase2_r1(p); }
#if PROBE_DOUBLE == 2
    phase2_r1(p);
#endif
#if PROBE_DOUBLE == 200
    for (int i_ = 0; i_ < 10; ++i_) GSYNC();
#endif
#if PROBE_DOUBLE == 12
    phase10_hn(p); phase10_hn(p);
#endif
    GSYNC(); STAMP();
    PH(3) phase3_scan(p);
    GSYNC(); STAMP();
    PH(4) { phase4_r3s(p, shm); phase4_r3(p); }
#if PROBE_DOUBLE == 4
    phase4_r3(p);
#endif
    GSYNC(); STAMP();
    PH(5) phase5_gemms(p, shm);
#if PROBE_DOUBLE == 5
    phase5_gemms(p, shm);
#endif
    GSYNC(); STAMP();
#if PROBE_DOUBLE == 6
    phase6_attn(p, shm, 1);
#endif
    PH(6) phase6_attn(p, shm);
    GSYNC(); STAMP();
    PH(7) { phase7_gates(p, shm); thin_phase<7>(p, shm); }
    STAMP();
    PH(8) { phase8_merge(p, shm); thin_phase<8>(p, shm); }
#if PROBE_DOUBLE == 8
    phase8_merge(p, shm);
#endif
    GSYNC(); STAMP();
    PH(9) { phase9_out(p, shm); thin_phase<9>(p, shm); }
    GSYNC(); STAMP();
    PH(11) phase11_gu(p, shm);
#if PROBE_DOUBLE == 11
    phase11_gu(p, shm);
#endif
    GSYNC(); STAMP();
    const bool fusedfin = gridDim.x == 256;
    PH(12) { phase12_down(p, shm, fusedfin); thin_phase<12>(p, shm); }
    GSYNC(); STAMP();
    PH(13) phase13_final(p, fusedfin ? TP : 0);
#ifdef TIMING_RUN
    STAMP();
    if (blockIdx.x == 0 && threadIdx.x == 0) {
        const unsigned long long d = tsb[TIMING_RUN + 1] - tsb[TIMING_RUN];
        const unsigned long long t0 = wall_clock64();
        while (wall_clock64() - t0 < d) __builtin_amdgcn_s_sleep(8);
    }
#endif
}

extern "C" void kernel_launch(void* const* d_in, const int* in_sizes, int n_in, void* d_out, int out_size, void* d_ws, size_t ws_size,
                              hipStream_t stream) {
    constexpr size_t kDynLds = 131072 + 16;
    static int grid_blocks = 0;
    if (!grid_blocks) {
        int dev = 0, cus = 0, per_cu = 0;
        hipGetDevice(&dev);
        hipDeviceGetAttribute(&cus, hipDeviceAttributeMultiprocessorCount, dev);
        hipFuncSetAttribute((const void*)fwd_megakernel, hipFuncAttributeMaxDynamicSharedMemorySize, (int)kDynLds);
        hipOccupancyMaxActiveBlocksPerMultiprocessor(&per_cu, fwd_megakernel, NTHREADS, kDynLds);
        if (per_cu < 1) per_cu = 1;
        grid_blocks = cus;
    }
    Params p{};
    const float** pp = (const float**)&p;
    for (int i = 0; i < 19; ++i) pp[i] = (const float*)d_in[i];
    p.out = (float*)d_out; p.ws = (char*)d_ws;
    hipMemsetAsync((char*)d_ws + OFF_CTR, 0, 65536 + 16896 * 4, stream);
    void* args[] = {&p};
    hipError_t e = hipLaunchCooperativeKernel((void*)fwd_megakernel, dim3(grid_blocks), dim3(NTHREADS), args, kDynLds, stream);
    if (e != hipSuccess) fprintf(stderr, "cooperative launch failed: %s (grid %d)\n", hipGetErrorString(e), grid_blocks);
}
```

```cpp
#include <hip/hip_runtime.h>
#include <hip/hip_cooperative_groups.h>
#include <cstdio>
#include <cstdint>
namespace cg = cooperative_groups;

typedef unsigned short bf16_t;
typedef short bf16x8 __attribute__((ext_vector_type(8)));
typedef float f32x4 __attribute__((ext_vector_type(4)));
typedef float f32x2 __attribute__((ext_vector_type(2)));
typedef float f32x16 __attribute__((ext_vector_type(16)));
typedef unsigned u32x4 __attribute__((ext_vector_type(4)));
typedef unsigned u32x2 __attribute__((ext_vector_type(2)));
typedef __bf16 bf16v2 __attribute__((ext_vector_type(2)));
#define DI __device__ __forceinline__

#ifndef PROBE_DOUBLE
#define PROBE_DOUBLE -1
#endif

constexpr int TP = 16384, TS = 512, TALL = 16896;
constexpr int NKV = 33280;
constexpr int NTHREADS = 512;

constexpr size_t SZ_WIN = 6144ull * 1024 * 2, SZ_WUQ = 1536ull * 512 * 2, SZ_WUKV = 2048ull * 256 * 2, SZ_W1K = 1024ull * 1024 * 2,
                 SZ_WGU = 5632ull * 1024 * 2, SZ_WDN = 1024ull * 2816 * 2;
constexpr size_t OFF_WIN = 0, OFF_WUQ = OFF_WIN + SZ_WIN, OFF_WUKV = OFF_WUQ + SZ_WUQ, OFF_WRO = OFF_WUKV + SZ_WUKV, OFF_WMO = OFF_WRO + SZ_W1K,
                 OFF_WOUT = OFF_WMO + SZ_W1K, OFF_WGU = OFF_WOUT + SZ_W1K, OFF_WDN = OFF_WGU + SZ_WGU;
constexpr size_t SZ_T1K = (size_t)TALL * 1024 * 2, SZ_T512 = (size_t)TALL * 512 * 2;
constexpr size_t OFF_XN = OFF_WDN + SZ_WDN;
constexpr size_t OFF_CKVALL = OFF_XN + SZ_T1K, SZ_CKVALL = (size_t)NKV * 256 * 2;
constexpr size_t OFF_KPEALL = OFF_CKVALL + SZ_CKVALL, SZ_KPEALL = (size_t)NKV * 64 * 2;
constexpr size_t OFF_POOL = OFF_KPEALL + SZ_KPEALL;
constexpr size_t OFF_CQ = OFF_POOL;
constexpr size_t OFF_RETIN = OFF_CQ + SZ_T512;
constexpr size_t OFF_CKVRAW = OFF_RETIN, OFF_KPERAW = OFF_CKVRAW + (size_t)TALL * 256 * 2;
constexpr size_t OFF_BIG = OFF_RETIN + SZ_T1K;
constexpr size_t OFF_RQ = OFF_BIG, OFF_RK = OFF_RQ + SZ_T512, OFF_RKT = OFF_RK + SZ_T512, OFF_RVT = OFF_RKT + SZ_T512, OFF_SRG = OFF_RVT + SZ_T1K;
constexpr size_t SZ_Q = (size_t)TALL * 1536 * 2, SZ_KNS = 8ull * 8 * 2112 * 128 * 2;
constexpr size_t OFF_Q = OFF_BIG, OFF_KNS = OFF_Q + SZ_Q, OFF_VTS = OFF_KNS + SZ_KNS;
constexpr size_t OFF_SGA = OFF_KNS, OFF_SGB = OFF_VTS;
constexpr size_t OFF_MERGED = OFF_XN, OFF_HN = OFF_CQ, OFF_ACT = OFF_BIG;
constexpr size_t OFF_CTR = OFF_BIG + 3 * SZ_T512 + 2 * SZ_T1K;
constexpr size_t OFF_BAR = OFF_CTR + 4096;
constexpr size_t OFF_ROWSS = OFF_CTR + 65536;
constexpr size_t OFF_PCNT = OFF_CTR + 32768;
constexpr size_t OFF_XBUF = OFF_CTR + 196608;
static_assert(OFF_XBUF + 64 * 4 * 256 * 4 <= 268435456ull, "xbuf");
static_assert(OFF_VTS + SZ_KNS == OFF_CTR, "mla overlay must match retention overlay");
static_assert(OFF_CTR + 65536 + 16896 * 4 <= 268435456ull, "workspace overflow");
constexpr size_t RKT_S = 2ull * 4 * 128 * 8192, RVT_S = 2ull * 4 * 256 * 8192;
constexpr size_t O_YP = 0, O_YS = 16777216, O_CKVP = 17301504, O_KPEP = 21495808, O_STP = 22544384, O_CKVS = 22806528, O_KPES = 22937600, O_STS = 22970368;
constexpr size_t SZ_KNP = 2ull * 8 * 8192 * 128 * 2;

__device__ const double THETA_REV[64] = {
0.15915494309189535, 0.13782250260398285, 0.11934937021124886, 0.10335229661843406, 0.08949940160889101, 0.07750328875537406, 0.06711508300522726, 0.058119267441876246, 0.050329212104487035, 0.04358330210530733, 0.03774158471741977, 0.032682865872357, 0.0283021958306234, 0.024508691862069852, 0.02122365276477766, 0.018378926105679667, 0.015915494309189534, 0.013782250260398284, 0.011934937021124886, 0.010335229661843406, 0.008949940160889102, 0.0077503288755374055, 0.006711508300522725, 0.005811926744187624, 0.005032921210448704, 0.004358330210530733, 0.003774158471741977, 0.0032682865872356993, 0.00283021958306234, 0.002450869186206985, 0.0021223652764777662, 0.0018378926105679667, 0.0015915494309189536, 0.0013782250260398288, 0.0011934937021124885, 0.0010335229661843405, 0.0008949940160889102, 0.0007750328875537405, 0.0006711508300522726, 0.0005811926744187624, 0.0005032921210448703, 0.0004358330210530733, 0.00037741584717419774, 0.0003268286587235699, 0.00028302195830623395, 0.00024508691862069854, 0.0002122365276477766, 0.00018378926105679666, 0.00015915494309189535, 0.00013782250260398286, 0.00011934937021124886, 0.00010335229661843406, 8.949940160889102e-05, 7.750328875537406e-05, 6.711508300522725e-05, 5.811926744187624e-05, 5.0329212104487035e-05, 4.358330210530732e-05, 3.774158471741978e-05, 3.2682865872357e-05, 2.8302195830623396e-05, 2.4508691862069852e-05, 2.122365276477766e-05, 1.8378926105679668e-05};

struct Params {
    const float *x_p, *x_s, *c_ckv, *c_kpe, *st, *nmix, *w_in, *qn, *w_uq, *kvn, *w_ukv, *gn, *w_ro, *w_mo, *w_out, *nffn, *w_gu, *w_dn, *nfin;
    float* out;
    char* ws;
};

DI float bf2f(bf16_t h) { return __uint_as_float((unsigned)h << 16); }
DI unsigned pk2(float lo, float hi) {
    f32x2 v = {lo, hi};
    bf16v2 b = __builtin_convertvector(v, bf16v2);
    return __builtin_bit_cast(unsigned, b);
}
DI bf16_t f2bf(float x) { return (bf16_t)(pk2(x, 0.f) & 0xffffu); }
DI u32x2 pk4(f32x4 v) { u32x2 r; r.x = pk2(v[0], v[1]); r.y = pk2(v[2], v[3]); return r; }
DI float fexp2(float x) { return __builtin_amdgcn_exp2f(x); }
DI float frcp(float x) { return __builtin_amdgcn_rcpf(x); }
DI float sigmoidf_(float x) { return frcp(1.0f + fexp2(-1.44269504089f * x)); }
DI float siluf_(float x) { return x * sigmoidf_(x); }
typedef unsigned u32v2_t __attribute__((ext_vector_type(2)));
DI float xhalf_max(float v) { const u32v2_t r = __builtin_amdgcn_permlane32_swap(__float_as_uint(v), __float_as_uint(v), false, false); return fmaxf(__uint_as_float(r.x), __uint_as_float(r.y)); }
DI float xhalf_sum(float v) { const u32v2_t r = __builtin_amdgcn_permlane32_swap(__float_as_uint(v), __float_as_uint(v), false, false); return __uint_as_float(r.x) + __uint_as_float(r.y); }
DI float wave_sum(float v) {
#pragma unroll
    for (int o = 32; o >= 1; o >>= 1) v += __shfl_xor(v, o);
    return v;
}
DI void rope_cs(int pos, int i, float& c, float& s) {
    double r = (double)pos * THETA_REV[i];
    r = r - __builtin_floor(r);
    const float rf = (float)r;
    s = __builtin_amdgcn_sinf(rf);
    c = __builtin_amdgcn_cosf(rf);
}
DI float lg2gamma(int h) { return h == 0 ? -0.04580368961312479f : h == 1 ? -0.02272007650008353f : h == 2 ? -0.011315313227834146f : -0.005646563141142063f; }
struct RowInfo { int isS, b, t, pos; };
DI RowInfo rinfo(int row) {
    RowInfo r;
    if (row < TP) { r.isS = 0; r.b = row >> 13; r.t = row & 8191; r.pos = r.t; }
    else { const int q = row - TP; r.isS = 1; r.b = q >> 6; r.t = q & 63; r.pos = 2048 + r.t; }
    return r;
}
DI int kvrow(const RowInfo& ri, int row) { return ri.isS ? (TP + ri.b * 2112 + 2048 + ri.t) : row; }

constexpr int BM = 256, BK = 64, HALF = 128, HT = HALF * BK;
DI int lds_byte(int r, int c) {
    int st = (r >> 4) * 2 + (c >> 5), rr = r & 15, cc = c & 31, ob = rr * 64 + cc * 2;
    return st * 1024 + (ob ^ (((ob >> 9) & 1) << 5));
}
DI void stage_rc(int b, int& R, int& C) {
    int st = b / 1024, sb = b % 1024, swz = sb ^ (((sb >> 9) & 1) << 5);
    R = (st >> 1) * 16 + swz / 64; C = (st & 1) * 32 + (swz % 64) / 2;
}
DI bool tile_order(int L, int nM, int nN, int& pm, int& pn) {
    const int nwg = nM * nN;
    if (L >= nwg) return false;
    int wgid = L;
    { const int q = nwg / 8, r = nwg % 8, xcd = wgid % 8, off = wgid / 8; wgid = (xcd < r ? xcd * (q + 1) : r * (q + 1) + (xcd - r) * q) + off; }
    const int nig = 8 * nN, gid = wgid / nig, fm = gid * 8, gsz = (nM - fm) < 8 ? (nM - fm) : 8;
    pm = fm + ((wgid % nig) % gsz); pn = (wgid % nig) / gsz;
    return true;
}

#define LAS __attribute__((address_space(3)))
DI void gemm_kloop(f32x4 (&acc)[2][2][4][2], const bf16_t* __restrict__ A, int lda, bool a192, const bf16_t* __restrict__ Bt, int ldb, int nt,
                   int brow, int bcol, LAS unsigned char* lds) {
    int tid = threadIdx.x; asm volatile("" : "+v"(tid));
    const int wid = __builtin_amdgcn_readfirstlane(tid >> 6), lane = tid & 63, wr = wid >> 2, wc = wid & 3, fr = lane & 15, fq = lane >> 4;
    unsigned voffA[2], voffB[2];
#pragma unroll
    for (int i = 0; i < 2; ++i) { int R, C; stage_rc(tid * 16 + i * 8192, R, C); voffA[i] = (unsigned)(R * lda + C) * 2u; voffB[i] = (unsigned)(R * ldb + C) * 2u; }
    const size_t hstepA = (size_t)HALF * lda * 2, hstepB = (size_t)HALF * ldb * 2;
    const unsigned ldsw = (unsigned)wid * 1024u;
    const int aoff = lds_byte(wr * 64 + fr, fq * 8), boff = lds_byte(wc * 32 + fr, fq * 8);
    const char* cA = (const char*)A + (size_t)brow * lda * 2;
    const char* cB = (const char*)Bt + (size_t)bcol * ldb * 2;
    constexpr int HTB = HALF * BK * 2;
#define SA(b, h) (((b) * 2 + (h)) * HTB)
#define SB(b, h) ((4 + (b) * 2 + (h)) * HTB)
#define AKO(kt) ((size_t)(a192 ? (((kt) >> 1) * 192 + ((kt) & 1) * 64) : (kt) * 64) * 2)
#define STAGE_(bufoff, gbase, voff) do { _Pragma("unroll") for (int _i = 0; _i < 2; ++_i) \
      __builtin_amdgcn_global_load_lds((const unsigned*)((const char*)(gbase) + (voff)[_i]), (LAS unsigned*)(lds + (bufoff) + ldsw + _i * 8192), 16, 0, 0); } while (0)
#define STAGEA(buf, h, kt) STAGE_(buf, cA + (h) * hstepA + AKO(kt), voffA)
#define STAGEB(buf, h, kt) STAGE_(buf, cB + (h) * hstepB + (size_t)(kt) * 128, voffB)
#define LDA(dst, b, h) do { _Pragma("unroll") for (int m = 0; m < 4; ++m) _Pragma("unroll") for (int k = 0; k < 2; ++k) dst[m][k] = *(const LAS bf16x8*)(lds + SA(b, h) + aoff + m * 2048 + k * 1024); } while (0)
#define LDB(dst, b, h) do { _Pragma("unroll") for (int n = 0; n < 2; ++n) _Pragma("unroll") for (int k = 0; k < 2; ++k) dst[n][k] = *(const LAS bf16x8*)(lds + SB(b, h) + boff + n * 2048 + k * 1024); } while (0)
#define MMA(ai, bj, At_, Bt_) do { __builtin_amdgcn_s_setprio(1); _Pragma("unroll") for (int m = 0; m < 4; ++m) _Pragma("unroll") for (int n = 0; n < 2; ++n) _Pragma("unroll") for (int k = 0; k < 2; ++k) \
      acc[ai][bj][m][n] = __builtin_amdgcn_mfma_f32_16x16x32_bf16(Bt_[n][k], At_[m][k], acc[ai][bj][m][n], 0, 0, 0); \
    __builtin_amdgcn_s_setprio(0); } while (0)
#define WAIT_V(n) asm volatile("s_waitcnt vmcnt(" #n ")" ::: "memory")
#define WAIT_L(n) asm volatile("s_waitcnt lgkmcnt(" #n ")" ::: "memory")
#define BAR __builtin_amdgcn_s_barrier()
#define SCHED __builtin_amdgcn_sched_barrier(0)
    bf16x8 At[4][2], B0[2][2], B1[2][2];
    WAIT_V(0);
    STAGEB(SB(0, 0), 0, 0); STAGEA(SA(0, 0), 0, 0);
    STAGEB(SB(0, 1), 1, 0); STAGEA(SA(0, 1), 1, 0);
    if (wr == 1) BAR;
    WAIT_V(4); BAR;
    STAGEB(SB(1, 0), 0, 1); STAGEA(SA(1, 0), 0, 1); STAGEB(SB(1, 1), 1, 1);
    WAIT_V(6); BAR;
    for (int t = 0; t < nt - 2; t += 2) {
        LDB(B0, 0, 0); SCHED; LDA(At, 0, 0); STAGEA(SA(1, 1), 1, t + 1);
        WAIT_L(8); BAR; WAIT_L(0); MMA(0, 0, At, B0); BAR; SCHED;
        LDB(B1, 0, 1); STAGEB(SB(0, 0), 0, t + 2);
        BAR; WAIT_L(0); MMA(0, 1, At, B1); BAR;
        LDA(At, 0, 1); STAGEA(SA(0, 0), 0, t + 2);
        BAR; WAIT_L(0); MMA(1, 0, At, B0); BAR; SCHED;
        STAGEB(SB(0, 1), 1, t + 2);
        WAIT_V(6); BAR; MMA(1, 1, At, B1); BAR;
        LDB(B0, 1, 0); SCHED; LDA(At, 1, 0); STAGEA(SA(0, 1), 1, t + 2);
        WAIT_L(8); BAR; WAIT_L(0); MMA(0, 0, At, B0); BAR; SCHED;
        LDB(B1, 1, 1); STAGEB(SB(1, 0), 0, t + 3);
        BAR; WAIT_L(0); MMA(0, 1, At, B1); BAR;
        LDA(At, 1, 1); STAGEA(SA(1, 0), 0, t + 3);
        BAR; WAIT_L(0); MMA(1, 0, At, B0); BAR; SCHED;
        STAGEB(SB(1, 1), 1, t + 3);
        WAIT_V(6); BAR; MMA(1, 1, At, B1); BAR;
    }
    { LDB(B0, 0, 0); LDA(At, 0, 0); STAGEA(SA(1, 1), 1, nt - 1);
      BAR; WAIT_L(0); MMA(0, 0, At, B0); BAR;
      LDB(B1, 0, 1); BAR; WAIT_L(0); MMA(0, 1, At, B1); BAR;
      LDA(At, 0, 1); WAIT_V(4); BAR; WAIT_L(0); MMA(1, 0, At, B0); MMA(1, 1, At, B1); BAR; }
    { LDB(B0, 1, 0); LDA(At, 1, 0); WAIT_V(2); BAR; WAIT_L(0); MMA(0, 0, At, B0); BAR;
      LDB(B1, 1, 1); WAIT_V(0); BAR; WAIT_L(0); MMA(0, 1, At, B1); BAR;
      LDA(At, 1, 1); BAR; WAIT_L(0); MMA(1, 0, At, B0); MMA(1, 1, At, B1); BAR; }
    if (wr == 0) BAR;
}
#define ZERO_ACC(acc) for (int a_ = 0; a_ < 2; ++a_) for (int b_ = 0; b_ < 2; ++b_) for (int m_ = 0; m_ < 4; ++m_) for (int n_ = 0; n_ < 2; ++n_) acc[a_][b_][m_][n_] = (f32x4){0.f, 0.f, 0.f, 0.f}
struct GUnit { const bf16_t* a; const bf16_t* b; int pm, pn; };
template <class Sched, class Epi>
DI void gemm_stream(LAS unsigned char* lds, int lda, bool a192, int ldb, int nt, const Sched& S, const Epi& E) {
    int tid = threadIdx.x; asm volatile("" : "+v"(tid));
    const int wid = __builtin_amdgcn_readfirstlane(tid >> 6), lane = tid & 63, wr = wid >> 2, wc = wid & 3, fr = lane & 15, fq = lane >> 4;
    GUnit cur, nxt; int ui = 0;
    if (!S.next(0, cur)) return;
    unsigned voffA[2], voffB[2];
#pragma unroll
    for (int i = 0; i < 2; ++i) { int R, C; stage_rc(tid * 16 + i * 8192, R, C); voffA[i] = (unsigned)(R * lda + C) * 2u; voffB[i] = (unsigned)(R * ldb + C) * 2u; }
    const size_t hstepA = (size_t)HALF * lda * 2, hstepB = (size_t)HALF * ldb * 2;
    const unsigned ldsw = (unsigned)wid * 1024u;
    const int aoff = lds_byte(wr * 64 + fr, fq * 8), boff = lds_byte(wc * 32 + fr, fq * 8);
    constexpr int HTB = HALF * BK * 2;
#define GS_STAGE(bufoff, gbase, voff) do { _Pragma("unroll") for (int _i = 0; _i < 2; ++_i) \
      __builtin_amdgcn_global_load_lds((const unsigned*)((const char*)(gbase) + (voff)[_i]), (LAS unsigned*)(lds + (bufoff) + ldsw + _i * 8192), 16, 0, 0); } while (0)
    f32x4 acc[2][2][4][2];
    ZERO_ACC(acc);
    bf16x8 At[4][2], B0[2][2], B1[2][2];
    const char* cA = (const char*)cur.a; const char* cB = (const char*)cur.b;
    WAIT_V(0);
    GS_STAGE(SB(0, 0), cB, voffB); GS_STAGE(SB(0, 1), cB + hstepB, voffB); GS_STAGE(SA(0, 0), cA, voffA); GS_STAGE(SA(0, 1), cA + hstepA, voffA);
    if (wr == 1) BAR;
    WAIT_V(2); BAR;
    GS_STAGE(SB(1, 0), cB + 128, voffB); GS_STAGE(SA(1, 0), cA + 128, voffA); GS_STAGE(SB(1, 1), cB + hstepB + 128, voffB);
    WAIT_V(6); BAR;
    for (;;) {
        const bool has_next = S.next(ui + 1, nxt);
        const char* nA = has_next ? (const char*)nxt.a : cA; const char* nB = has_next ? (const char*)nxt.b : cB;
        for (int t = 0; t < nt; t += 2) {
            const bool last = (t == nt - 2);
            const char* a1 = cA + AKO(t + 1);
            const char* a2 = last ? nA : cA + AKO(t + 2); const char* b2 = last ? nB : cB + (size_t)(t + 2) * 128;
            const char* a3 = a2 + 128; const char* b3 = b2 + 128;
            LDB(B0, 0, 0); LDB(B1, 0, 1); SCHED; LDA(At, 0, 0); GS_STAGE(SA(1, 1), a1 + hstepA, voffA);
            WAIT_V(8); WAIT_L(0); BAR; MMA(0, 0, At, B0); MMA(0, 1, At, B1); BAR; SCHED;
            LDA(At, 0, 1); GS_STAGE(SB(0, 0), b2, voffB); GS_STAGE(SB(0, 1), b2 + hstepB, voffB); GS_STAGE(SA(0, 0), a2, voffA);
            WAIT_V(8); WAIT_L(0); BAR; MMA(1, 0, At, B0); MMA(1, 1, At, B1); BAR; SCHED;
            LDB(B0, 1, 0); LDB(B1, 1, 1); SCHED; LDA(At, 1, 0); GS_STAGE(SA(0, 1), a2 + hstepA, voffA);
            WAIT_V(8); WAIT_L(0); BAR; MMA(0, 0, At, B0); MMA(0, 1, At, B1); BAR; SCHED;
            LDA(At, 1, 1); GS_STAGE(SB(1, 0), b3, voffB); GS_STAGE(SB(1, 1), b3 + hstepB, voffB); GS_STAGE(SA(1, 0), a3, voffA);
            WAIT_V(8); WAIT_L(0); BAR; MMA(1, 0, At, B0); MMA(1, 1, At, B1); BAR; SCHED;
        }
        E(acc, cur);
        if (!has_next) break;
        ZERO_ACC(acc);
        cur = nxt; cA = nA; cB = nB; ++ui;
    }
    WAIT_V(0);
    if (wr == 0) BAR;
    BAR;
#undef GS_STAGE
}
#define EPI_IDS int lane = threadIdx.x & 63, wid = __builtin_amdgcn_readfirstlane(threadIdx.x >> 6); asm volatile("" : "+v"(lane), "+s"(wid)); const int wr = wid >> 2, wc = wid & 3, fr = lane & 15, fq = lane >> 4

template <class F>
DI void conv_w(const float* __restrict__ W, int K, int Norig, bf16_t* __restrict__ Wt, int Nt, F perm, LAS unsigned char* lds) {
    int tid = threadIdx.x; asm volatile("" : "+v"(tid));
    const int lane = tid & 63, w = tid >> 6, nl = tid >> 3, ch = tid & 7;
    const int ntn = Nt / 64, total = (K / 64) * ntn;
    float v[8], vn[8];
    int t = blockIdx.x;
    if (t < total) {
        const int tn = t % ntn, tk = t / ntn, col = perm(tn * 64 + lane);
#pragma unroll
        for (int j = 0; j < 8; ++j) v[j] = col >= 0 ? W[(size_t)(tk * 64 + w * 8 + j) * Norig + col] : 0.f;
    }
    for (; t < total; t += gridDim.x) {
        const int t2 = t + gridDim.x;
        if (t2 < total) {
            const int tn = t2 % ntn, tk = t2 / ntn, col = perm(tn * 64 + lane);
#pragma unroll
            for (int j = 0; j < 8; ++j) vn[j] = col >= 0 ? W[(size_t)(tk * 64 + w * 8 + j) * Norig + col] : 0.f;
        }
        const int tn = t % ntn, tk = t / ntn;
        __syncthreads();
        u32x4 o; o.x = pk2(v[0], v[1]); o.y = pk2(v[2], v[3]); o.z = pk2(v[4], v[5]); o.w = pk2(v[6], v[7]);
        *(LAS u32x4*)(lds + lane * 144 + w * 16) = o;
        __syncthreads();
        *(u32x4*)(Wt + (size_t)(tn * 64 + nl) * K + tk * 64 + ch * 8) = *(const LAS u32x4*)(lds + nl * 144 + ch * 16);
#pragma unroll
        for (int j = 0; j < 8; ++j) v[j] = vn[j];
    }
    __syncthreads();
}
DI int perm_win(int n) {
    const int tc = n >> 8, c = n & 255;
    if (tc < 4) { const int half = c >> 7, e = (c >> 6) & 1, i = c & 63; return (tc >> 1) * 512 + (2 * (tc & 1) + e) * 128 + half * 64 + i; }
    if (tc < 15) return n;
    if (tc == 15) return c < 64 ? 3840 + c : -1;
    return 3904 + (n - 4096);
}
DI int perm_wuq(int n) {
    const int tc = n >> 8, c = n & 255;
    if (tc < 4) { const int e = c >> 7, d = c & 127; return (2 * tc + e) * 192 + d; }
    const int half = c >> 7, e = (c >> 5) & 3, i = c & 31;
    return (4 * (tc - 4) + e) * 192 + 128 + half * 32 + i;
}
DI int perm_wukv(int n) {
    const int tc = n >> 8, c = n & 255;
    const int e = c >> 7, d = c & 127;
    if (tc < 4) return (2 * tc + e) * 256 + d;
    return (2 * (tc - 4) + e) * 256 + 128 + d;
}
DI int perm_wgu(int n) { const int tc = n >> 8, c = n & 255; return (c >> 7) * 2816 + tc * 128 + (c & 127); }
DI int perm_id(int n) { return n; }

DI void rmsnorm_row_1024(const float* __restrict__ x, const float* __restrict__ g, bf16_t* __restrict__ o, int lane) {
    f32x4 v[4]; float ss = 0.f;
#pragma unroll
    for (int i = 0; i < 4; ++i) { v[i] = *(const f32x4*)(x + i * 256 + lane * 4); ss += v[i][0] * v[i][0] + v[i][1] * v[i][1] + v[i][2] * v[i][2] + v[i][3] * v[i][3]; }
    ss = wave_sum(ss);
    const float rstd = rsqrtf(ss * (1.0f / 1024.0f) + 1e-6f);
#pragma unroll
    for (int i = 0; i < 4; ++i) { const f32x4 gg = *(const f32x4*)(g + i * 256 + lane * 4); *(u32x2*)(o + i * 256 + lane * 4) = pk4(v[i] * rstd * gg); }
}

DI void rmsnorm_row2_1024(const float* __restrict__ xa, const float* __restrict__ xb, const float* __restrict__ g, bf16_t* __restrict__ oa, bf16_t* __restrict__ ob, int lane) {
    f32x4 va[4], vb[4]; float sa = 0.f, sb = 0.f;
#pragma unroll
    for (int i = 0; i < 4; ++i) { va[i] = *(const f32x4*)(xa + i * 256 + lane * 4); vb[i] = *(const f32x4*)(xb + i * 256 + lane * 4); }
#pragma unroll
    for (int i = 0; i < 4; ++i) { sa += va[i][0] * va[i][0] + va[i][1] * va[i][1] + va[i][2] * va[i][2] + va[i][3] * va[i][3]; sb += vb[i][0] * vb[i][0] + vb[i][1] * vb[i][1] + vb[i][2] * vb[i][2] + vb[i][3] * vb[i][3]; }
    sa = wave_sum(sa); sb = wave_sum(sb);
    const float ra = rsqrtf(sa * (1.0f / 1024.0f) + 1e-6f), rb = rsqrtf(sb * (1.0f / 1024.0f) + 1e-6f);
#pragma unroll
    for (int i = 0; i < 4; ++i) { const f32x4 gg = *(const f32x4*)(g + i * 256 + lane * 4); *(u32x2*)(oa + i * 256 + lane * 4) = pk4(va[i] * ra * gg); *(u32x2*)(ob + i * 256 + lane * 4) = pk4(vb[i] * rb * gg); }
}

DI void phase0(const Params& p, LAS unsigned char* lds) {
    const int gtid = blockIdx.x * NTHREADS + threadIdx.x, nth = gridDim.x * NTHREADS;
    char* ws = p.ws;
    if (gtid < 64) ((unsigned*)(ws + OFF_CTR))[gtid] = (gtid == 33) ? 1u : 0u;
    conv_w(p.w_in, 1024, 5952, (bf16_t*)(ws + OFF_WIN), 6144, perm_win, lds);
    conv_w(p.w_uq, 512, 1536, (bf16_t*)(ws + OFF_WUQ), 1536, perm_wuq, lds);
    conv_w(p.w_ukv, 256, 2048, (bf16_t*)(ws + OFF_WUKV), 2048, perm_wukv, lds);
    conv_w(p.w_ro, 1024, 1024, (bf16_t*)(ws + OFF_WRO), 1024, perm_id, lds);
    conv_w(p.w_mo, 1024, 1024, (bf16_t*)(ws + OFF_WMO), 1024, perm_id, lds);
    conv_w(p.w_out, 1024, 1024, (bf16_t*)(ws + OFF_WOUT), 1024, perm_id, lds);
    conv_w(p.w_gu, 1024, 5632, (bf16_t*)(ws + OFF_WGU), 5632, perm_wgu, lds);
    conv_w(p.w_dn, 2816, 1024, (bf16_t*)(ws + OFF_WDN), 1024, perm_id, lds);
    const int gw = gtid >> 6, nw = nth >> 6, lane = threadIdx.x & 63;
    bf16_t* xn = (bf16_t*)(ws + OFF_XN);
    for (int row = gw; row < TALL; row += 2 * nw) {
        const int row2 = row + nw;
        const float* x = row < TP ? p.x_p + (size_t)row * 1024 : p.x_s + (size_t)(row - TP) * 1024;
        if (row2 < TALL) {
            const float* x2 = row2 < TP ? p.x_p + (size_t)row2 * 1024 : p.x_s + (size_t)(row2 - TP) * 1024;
            rmsnorm_row2_1024(x, x2, p.nmix, xn + (size_t)row * 1024, xn + (size_t)row2 * 1024, lane);
        } else rmsnorm_row_1024(x, p.nmix, xn + (size_t)row * 1024, lane);
    }
    bf16_t* ckvall = (bf16_t*)(ws + OFF_CKVALL); bf16_t* kpeall = (bf16_t*)(ws + OFF_KPEALL);
    for (int idx = gtid; idx < 8 * 2048 * 64; idx += nth) {
        const int c4 = idx & 63, r = idx >> 6, b = r >> 11, j = r & 2047;
        const f32x4 v = *(const f32x4*)(p.c_ckv + (size_t)r * 256 + c4 * 4);
        *(u32x2*)(ckvall + (size_t)(TP + b * 2112 + j) * 256 + c4 * 4) = pk4(v);
    }
    for (int idx = gtid; idx < 8 * 2048 * 16; idx += nth) {
        const int c4 = idx & 15, r = idx >> 4, b = r >> 11, j = r & 2047;
        const f32x4 v = *(const f32x4*)(p.c_kpe + (size_t)r * 64 + c4 * 4);
        *(u32x2*)(kpeall + (size_t)(TP + b * 2112 + j) * 64 + c4 * 4) = pk4(v);
    }
}

DI void epi_win(const Params& p, const f32x4 (&acc)[2][2][4][2], int pm, int tc) {
    EPI_IDS;
    char* ws = p.ws;
    const int row0 = pm * 256 + wr * 64 + fr;
    if (tc < 4) {
        const bool isK = tc >= 2;
        bf16_t* nat = (bf16_t*)(ws + (isK ? OFF_RK : OFF_RQ));
        const float sc = isK ? 0.08838834764831845f : 1.0f;
#pragma unroll
        for (int ai = 0; ai < 2; ++ai)
#pragma unroll
            for (int m = 0; m < 4; ++m) {
                const int row = row0 + ai * 128 + m * 16;
                const RowInfo ri = rinfo(row);
#pragma unroll
                for (int n = 0; n < 2; ++n) {
                    const int cw = wc * 32 + n * 16 + fq * 4, e = cw >> 6, i0 = cw & 63, head = 2 * (tc & 1) + e;
                    const f32x4 x1 = acc[ai][0][m][n], x2 = acc[ai][1][m][n];
                    f32x4 o1, o2;
#pragma unroll
                    for (int j = 0; j < 4; ++j) { float c, s; rope_cs(ri.pos, i0 + j, c, s); o1[j] = (x1[j] * c - x2[j] * s) * sc; o2[j] = (x1[j] * s + x2[j] * c) * sc; }
                    *(u32x2*)(nat + (size_t)row * 512 + head * 128 + i0) = pk4(o1);
                    *(u32x2*)(nat + (size_t)row * 512 + head * 128 + 64 + i0) = pk4(o2);
                }
            }
    } else {
        bf16_t* dst; int ld, cbase, act = 0;
        if (tc < 12) { dst = (bf16_t*)(ws + OFF_SRG); ld = 1024; cbase = (tc - 8) * 256; act = 1; }
        else if (tc < 14) { dst = (bf16_t*)(ws + OFF_CQ); ld = 512; cbase = (tc - 12) * 256; }
        else if (tc == 14) { dst = (bf16_t*)(ws + OFF_CKVRAW); ld = 256; cbase = 0; }
        else if (tc == 15) { dst = (bf16_t*)(ws + OFF_KPERAW); ld = 64; cbase = 0; }
        else if (tc < 20) { dst = (bf16_t*)(ws + OFF_SGA); ld = 1024; cbase = (tc - 16) * 256; act = 2; }
        else { dst = (bf16_t*)(ws + OFF_SGB); ld = 1024; cbase = (tc - 20) * 256; act = 2; }
#pragma unroll
        for (int ai = 0; ai < 2; ++ai)
#pragma unroll
            for (int m = 0; m < 4; ++m) {
                const int row = row0 + ai * 128 + m * 16;
#pragma unroll
                for (int bj = 0; bj < 2; ++bj)
#pragma unroll
                    for (int n = 0; n < 2; ++n) {
                        const int c = bj * 128 + wc * 32 + n * 16 + fq * 4;
                        if (tc == 15 && c >= 64) continue;
                        f32x4 v = acc[ai][bj][m][n];
                        if (act == 1) { for (int j = 0; j < 4; ++j) v[j] = siluf_(v[j]); }
                        else if (act == 2) { for (int j = 0; j < 4; ++j) v[j] = sigmoidf_(v[j]); }
                        *(u32x2*)(dst + (size_t)row * ld + cbase + c) = pk4(v);
                    }
            }
    }
}
DI void epi_win_T(const Params& p, const f32x4 (&acc)[2][2][4][2], int pm, int tc) {
    EPI_IDS;
    char* ws = p.ws;
    if (tc < 4) {
        bf16_t* rkt = (bf16_t*)(ws + OFF_RKT);
        const int head = 2 * (tc & 1) + wr;
        const float lg = lg2gamma(head), sc = 0.08838834764831845f;
#pragma unroll
        for (int bj = 0; bj < 2; ++bj)
#pragma unroll
            for (int n = 0; n < 2; ++n) {
                const int tok0 = pm * 256 + bj * 128 + wc * 32 + n * 16 + fq * 4;
                const RowInfo ri = rinfo(tok0);
                bf16_t* dst = ri.isS ? rkt + RKT_S + (size_t)(ri.b * 4 + head) * 8192 + ri.t
                                     : rkt + ((size_t)(ri.b * 4 + head) * 128 + (ri.t >> 6)) * 8192 + (ri.t & 63);
                f32x4 dec;
#pragma unroll
                for (int j = 0; j < 4; ++j) dec[j] = sc * fexp2((float)(63 - ((ri.t + j) & 63)) * lg);
#pragma unroll
                for (int m = 0; m < 4; ++m) {
                    const int i = m * 16 + fr;
                    const f32x4 x1 = acc[0][bj][m][n], x2 = acc[1][bj][m][n];
                    f32x4 o1, o2;
#pragma unroll
                    for (int j = 0; j < 4; ++j) { float c, s; rope_cs(ri.pos + j, i, c, s); o1[j] = (x1[j] * c - x2[j] * s) * dec[j]; o2[j] = (x1[j] * s + x2[j] * c) * dec[j]; }
                    *(u32x2*)(dst + i * 64) = pk4(o1);
                    *(u32x2*)(dst + (64 + i) * 64) = pk4(o2);
                }
            }
    } else {
        bf16_t* rvt = (bf16_t*)(ws + OFF_RVT);
        const int head = tc - 4;
#pragma unroll
        for (int bj = 0; bj < 2; ++bj)
#pragma unroll
            for (int n = 0; n < 2; ++n) {
                const int tok0 = pm * 256 + bj * 128 + wc * 32 + n * 16 + fq * 4;
                const RowInfo ri = rinfo(tok0);
                bf16_t* dst = ri.isS ? rvt + RVT_S + (size_t)(ri.b * 4 + head) * 16384 + ri.t
                                     : rvt + ((size_t)(ri.b * 4 + head) * 128 + (ri.t >> 6)) * 16384 + (ri.t & 63);
#pragma unroll
                for (int ai = 0; ai < 2; ++ai)
#pragma unroll
                    for (int m = 0; m < 4; ++m) *(u32x2*)(dst + (ai * 128 + wr * 64 + m * 16 + fr) * 64) = pk4(acc[ai][bj][m][n]);
            }
    }
}
DI void phase_gemm_in(const Params& p, int tc0, int ntc, LAS unsigned char* shm, int nM = TALL / 256) {
    const bf16_t* A = (const bf16_t*)(p.ws + OFF_XN);
    const bf16_t* Bt = (const bf16_t*)(p.ws + OFF_WIN);
    for (int L = blockIdx.x;; L += gridDim.x) {
        int pm, pn; if (!tile_order(L, nM, ntc, pm, pn)) break;
        f32x4 acc[2][2][4][2]; ZERO_ACC(acc);
        gemm_kloop(acc, A, 1024, false, Bt, 1024, 16, pm * 256, (tc0 + pn) * 256, shm);
        epi_win(p, acc, pm, tc0 + pn);
    }
}

DI void phase7_gates(const Params& p, LAS unsigned char* shm) {
    const bf16_t* A = (const bf16_t*)(p.ws + OFF_XN);
    const bf16_t* Bt = (const bf16_t*)(p.ws + OFF_WIN);
#pragma unroll 1
    for (int g = 0; g < 2; ++g)
        for (int L = blockIdx.x;; L += gridDim.x) {
            int pm, pn; if (!tile_order(L, 64, 4, pm, pn)) break;
            const int tc = 16 + 4 * g + pn;
            f32x4 acc[2][2][4][2]; ZERO_ACC(acc);
            gemm_kloop(acc, A, 1024, false, Bt, 1024, 16, pm * 256, tc * 256, shm);
            epi_win(p, acc, pm, tc);
        }
}
struct SchedP1 {
    const bf16_t* X; const bf16_t* W;
    DI bool next(int i, GUnit& u) const {
        int pm, pn; if (!tile_order(blockIdx.x + i * gridDim.x, TALL / 256, 18, pm, pn)) return false;
        u.pm = pm; u.pn = pn;
        if (pn < 12) { const int tc = pn < 4 ? pn : pn + 4; u.a = X + (size_t)pm * 256 * 1024; u.b = W + (size_t)tc * 256 * 1024; }
        else { const int tc = pn - 10; u.a = W + (size_t)tc * 256 * 1024; u.b = X + (size_t)pm * 256 * 1024; }
        return true;
    }
};
struct EpiP1 {
    Params p;
    DI void operator()(const f32x4 (&acc)[2][2][4][2], const GUnit& u) const {
        if (u.pn < 12) epi_win(p, acc, u.pm, u.pn < 4 ? u.pn : u.pn + 4); else epi_win_T(p, acc, u.pm, u.pn - 10);
    }
};
DI void phase1_gemm(const Params& p, LAS unsigned char* shm) {
    const SchedP1 S{(const bf16_t*)(p.ws + OFF_XN), (const bf16_t*)(p.ws + OFF_WIN)};
    const EpiP1 E{p};
    gemm_stream(shm, 1024, false, 1024, 16, S, E);
}

DI void phase2_elem(const Params& p) {
    const int skip = gridDim.x > 64 ? 32 : 0;
    if ((int)blockIdx.x < skip) return;
    const int gw = ((int)blockIdx.x - skip) * 8 + (threadIdx.x >> 6), nw = ((int)gridDim.x - skip) * 8, lane = threadIdx.x & 63;
    char* ws = p.ws;
    bf16_t* cq = (bf16_t*)(ws + OFF_CQ);
    const bf16_t* ckvraw = (const bf16_t*)(ws + OFF_CKVRAW);
    const bf16_t* kperaw = (const bf16_t*)(ws + OFF_KPERAW);
    bf16_t* ckvall = (bf16_t*)(ws + OFF_CKVALL); bf16_t* kpeall = (bf16_t*)(ws + OFF_KPEALL);
    for (int row = gw; row < TALL; row += nw) {
        const RowInfo ri = rinfo(row);
        const int kr = kvrow(ri, row);
        {
            const u32x4 raw = *(const u32x4*)(cq + (size_t)row * 512 + lane * 8);
            float v[8];
#pragma unroll
            for (int j = 0; j < 4; ++j) { v[2 * j] = __uint_as_float(raw[j] << 16); v[2 * j + 1] = __uint_as_float(raw[j] & 0xffff0000u); }
            float ss = 0.f;
#pragma unroll
            for (int j = 0; j < 8; ++j) ss += v[j] * v[j];
            ss = wave_sum(ss);
            const float rstd = rsqrtf(ss * (1.0f / 512.0f) + 1e-6f);
            const f32x4 g0 = *(const f32x4*)(p.qn + lane * 8), g1 = *(const f32x4*)(p.qn + lane * 8 + 4);
            u32x4 o; o.x = pk2(v[0] * rstd * g0[0], v[1] * rstd * g0[1]); o.y = pk2(v[2] * rstd * g0[2], v[3] * rstd * g0[3]);
            o.z = pk2(v[4] * rstd * g1[0], v[5] * rstd * g1[1]); o.w = pk2(v[6] * rstd * g1[2], v[7] * rstd * g1[3]);
            *(u32x4*)(cq + (size_t)row * 512 + lane * 8) = o;
        }
        {
            const u32x2 raw = *(const u32x2*)(ckvraw + (size_t)row * 256 + lane * 4);
            f32x4 v; v[0] = __uint_as_float(raw.x << 16); v[1] = __uint_as_float(raw.x & 0xffff0000u); v[2] = __uint_as_float(raw.y << 16); v[3] = __uint_as_float(raw.y & 0xffff0000u);
            float ss = v[0] * v[0] + v[1] * v[1] + v[2] * v[2] + v[3] * v[3];
            ss = wave_sum(ss);
            const float rstd = rsqrtf(ss * (1.0f / 256.0f) + 1e-6f);
            const f32x4 g = *(const f32x4*)(p.kvn + lane * 4);
            const f32x4 o = v * rstd * g;
            float* od = ri.isS ? p.out + O_CKVS + ((size_t)(ri.b * 64 + ri.t)) * 256 : p.out + O_CKVP + (size_t)row * 256;
            *(f32x4*)(od + lane * 4) = o;
            *(u32x2*)(ckvall + (size_t)kr * 256 + lane * 4) = pk4(o);
        }
        {
            const int i = lane & 31;
            const float x1 = bf2f(kperaw[(size_t)row * 64 + i]), x2 = bf2f(kperaw[(size_t)row * 64 + 32 + i]);
            float c, s; rope_cs(ri.pos, 2 * i, c, s);
            const float o1 = x1 * c - x2 * s, o2 = x1 * s + x2 * c;
            float* od = ri.isS ? p.out + O_KPES + ((size_t)(ri.b * 64 + ri.t)) * 64 : p.out + O_KPEP + (size_t)row * 64;
            if (lane < 32) { od[i] = o1; od[32 + i] = o2; kpeall[(size_t)kr * 64 + i] = f2bf(o1); kpeall[(size_t)kr * 64 + 32 + i] = f2bf(o2); }
        }
    }
}

#define MFMA32(a, b, c) __builtin_amdgcn_mfma_f32_32x32x16_bf16((a), (b), (c), 0, 0, 0)
DI int pi32(int r) { return (r & 0x13) | ((r & 4) << 1) | ((r & 8) >> 1); }
DI int crow(int reg, int hh) { return (reg & 3) + 8 * (reg >> 2) + 4 * hh; }
DI bf16x8 pack8(const float (&v)[8]) {
    u32x4 o; o.x = pk2(v[0], v[1]); o.y = pk2(v[2], v[3]); o.z = pk2(v[4], v[5]); o.w = pk2(v[6], v[7]);
    return __builtin_bit_cast(bf16x8, o);
}
DI f32x16 zero16() { f32x16 z; for (int i = 0; i < 16; ++i) z[i] = 0.f; return z; }

DI void phase2_r1(const Params& p) {
    int tid = threadIdx.x; asm volatile("" : "+v"(tid));
    const int lane = tid & 63, w = __builtin_amdgcn_readfirstlane(tid >> 6), l31 = lane & 31, hh = lane >> 5;
    const bf16_t* rkt = (const bf16_t*)(p.ws + OFF_RKT);
    const bf16_t* rvt = (const bf16_t*)(p.ws + OFF_RVT);
    bf16_t* kvst = (bf16_t*)p.out;
    bf16_t* ss = (bf16_t*)(p.out + O_YS);
    for (int u = blockIdx.x; u < 1056; u += gridDim.x) {
        const bf16_t *ka, *va; size_t ts;
        ts = 64;
        if (u < 1024) { ka = rkt + (size_t)u * 8192; va = rvt + (size_t)u * 16384; }
        else { const int s = u - 1024; ka = rkt + RKT_S + (size_t)s * 8192; va = rvt + RVT_S + (size_t)s * 16384; }
        f32x16 acc[4];
#pragma unroll
        for (int i = 0; i < 4; ++i) acc[i] = zero16();
#define R1_LOAD(A_, B_, ks) do { A_ = *(const bf16x8*)(va + (size_t)(32 * w + l31) * ts + (ks) * 16 + hh * 8); \
            _Pragma("unroll") for (int dkt = 0; dkt < 4; ++dkt) B_[dkt] = *(const bf16x8*)(ka + (size_t)(dkt * 32 + l31) * ts + (ks) * 16 + hh * 8); } while (0)
#define R1_MMA(A_, B_) do { _Pragma("unroll") for (int dkt = 0; dkt < 4; ++dkt) acc[dkt] = MFMA32(B_[dkt], A_, acc[dkt]); } while (0)
        bf16x8 a0, a1, b0[4], b1[4];
        R1_LOAD(a0, b0, 0);
        __builtin_amdgcn_sched_barrier(0);
        R1_LOAD(a1, b1, 1); R1_MMA(a0, b0);
        __builtin_amdgcn_sched_barrier(0);
        R1_LOAD(a0, b0, 2); R1_MMA(a1, b1);
        __builtin_amdgcn_sched_barrier(0);
        R1_LOAD(a1, b1, 3); R1_MMA(a0, b0);
        __builtin_amdgcn_sched_barrier(0);
        R1_MMA(a1, b1);
        if (u < 1024) {
            bf16_t* o = kvst + (size_t)u * 32768;
#pragma unroll
            for (int dkt = 0; dkt < 4; ++dkt)
#pragma unroll
                for (int g = 0; g < 4; ++g) {
                    f32x4 v; v[0] = acc[dkt][4 * g]; v[1] = acc[dkt][4 * g + 1]; v[2] = acc[dkt][4 * g + 2]; v[3] = acc[dkt][4 * g + 3];
                    *(u32x2*)(o + (32 * w + l31) * 128 + dkt * 32 + 8 * g + 4 * hh) = pk4(v);
                }
        } else {
            const int s = u - 1024, h = s & 3;
            const float G = fexp2(64.0f * lg2gamma(h));
            const float* sin_ = p.st + (size_t)s * 32768;
            float* so = p.out + O_STS + (size_t)s * 32768;
            bf16_t* o = ss + (size_t)s * 32768;
#pragma unroll
            for (int dkt = 0; dkt < 4; ++dkt) {
                float sv[16];
#pragma unroll
                for (int reg = 0; reg < 16; ++reg) sv[reg] = sin_[(dkt * 32 + crow(reg, hh)) * 256 + 32 * w + l31];
#pragma unroll
                for (int reg = 0; reg < 16; ++reg) so[(dkt * 32 + crow(reg, hh)) * 256 + 32 * w + l31] = G * sv[reg] + acc[dkt][reg];
#pragma unroll
                for (int g = 0; g < 4; ++g) {
                    f32x4 v; v[0] = sv[4 * g]; v[1] = sv[4 * g + 1]; v[2] = sv[4 * g + 2]; v[3] = sv[4 * g + 3];
                    *(u32x2*)(o + (32 * w + l31) * 128 + dkt * 32 + 8 * g + 4 * hh) = pk4(v);
                }
            }
        }
    }
}
DI void phase3_scan(const Params& p) {
    const int gtid = blockIdx.x * NTHREADS + threadIdx.x, nth = gridDim.x * NTHREADS;
    bf16_t* kvst = (bf16_t*)p.out;
    for (int pidx = gtid; pidx < 8 * 16384; pidx += nth) {
        const int bh = pidx >> 14, e = (pidx & 16383) * 2, h = bh & 3;
        const float G = fexp2(64.0f * lg2gamma(h));
        float s0 = 0.f, s1 = 0.f;
        unsigned* ptr = (unsigned*)(kvst + (size_t)bh * 128 * 32768 + e);
#pragma unroll 1
        for (int c0 = 0; c0 < 128; c0 += 32) {
            unsigned v[32];
#pragma unroll
            for (int i = 0; i < 32; ++i) v[i] = ptr[(size_t)(c0 + i) * 16384];
#pragma unroll
            for (int i = 0; i < 32; ++i) {
                ptr[(size_t)(c0 + i) * 16384] = pk2(s0, s1);
                s0 = G * s0 + __uint_as_float(v[i] << 16); s1 = G * s1 + __uint_as_float(v[i] & 0xffff0000u);
            }
        }
        const int dv = e >> 7, dk = e & 127;
        float* so = p.out + O_STP + (size_t)bh * 32768;
        so[dk * 256 + dv] = s0; so[(dk + 1) * 256 + dv] = s1;
    }
}
DI f32x4 unpk4_(u32x2 b) { f32x4 r; r[0] = __uint_as_float(b.x << 16); r[1] = __uint_as_float(b.x & 0xffff0000u); r[2] = __uint_as_float(b.y << 16); r[3] = __uint_as_float(b.y & 0xffff0000u); return r; }
DI void r3_sample_unit(const Params& p, int s, LAS unsigned char* lds) {
    int tid = threadIdx.x; asm volatile("" : "+v"(tid));
    const int lane = tid & 63, w = __builtin_amdgcn_readfirstlane(tid >> 6), l31 = lane & 31, hh = lane >> 5;
    const bf16_t* rq = (const bf16_t*)(p.ws + OFF_RQ);
    const bf16_t* rk = (const bf16_t*)(p.ws + OFF_RK);
    const bf16_t* srg = (const bf16_t*)(p.ws + OFF_SRG);
    bf16_t* retin = (bf16_t*)(p.ws + OFF_RETIN);
    const int qh = w & 1, dq = w >> 1, h = s & 3, rowbase = TP + (s >> 2) * 64;
    const bf16_t* stp = (const bf16_t*)(p.out + O_YS) + (size_t)s * 32768 + (size_t)dq * 64 * 128;
    const bf16_t* vt = (const bf16_t*)(p.ws + OFF_RVT) + RVT_S + (size_t)s * 16384 + (size_t)dq * 64 * 64;
    const int l = qh * 32 + l31;
    const float lg = lg2gamma(h);
    const char* qbase = (const char*)(rq + (size_t)(rowbase + qh * 32) * 512 + h * 128);
    const unsigned qoff = (unsigned)(l31 * 512 + hh * 8) * 2u;
    f32x16 acc[2]; acc[0] = zero16(); acc[1] = zero16();
    const unsigned soff = (unsigned)(l31 * 128 + hh * 8) * 2u;
#pragma unroll
    for (int ks = 0; ks < 8; ++ks) {
        const bf16x8 bq = *(const bf16x8*)(qbase + qoff + ks * 32);
#pragma unroll
        for (int t = 0; t < 2; ++t) { const bf16x8 a = *(const bf16x8*)((const char*)stp + soff + t * 8192 + ks * 32); acc[t] = MFMA32(a, bq, acc[t]); }
    }
    const float qd = fexp2((float)(l + 1) * lg);
    acc[0] *= qd; acc[1] *= qd;
    const unsigned voff = (unsigned)(l31 * 64 + hh * 8) * 2u;
    const unsigned koff = (unsigned)(pi32(l31) * 512 + hh * 8) * 2u;
    for (int kt = 0; kt <= qh; ++kt) {
        f32x16 sc = zero16();
        const char* kbase = (const char*)(rk + (size_t)(rowbase + kt * 32) * 512 + h * 128);
#pragma unroll
        for (int ks = 0; ks < 8; ++ks) { const bf16x8 a = *(const bf16x8*)(kbase + koff + ks * 32); const bf16x8 bq = *(const bf16x8*)(qbase + qoff + ks * 32); sc = MFMA32(a, bq, sc); }
#pragma unroll
        for (int st = 0; st < 2; ++st) {
            float v[8];
#pragma unroll
            for (int j = 0; j < 8; ++j) { const int reg = 8 * st + j, m = kt * 32 + pi32(crow(reg, hh)), d = l - m; v[j] = d >= 0 ? sc[reg] * fexp2((float)d * lg) : 0.f; }
            const bf16x8 P = pack8(v);
            const char* vbase = (const char*)vt + (kt * 2 + st) * 32;
#pragma unroll
            for (int t = 0; t < 2; ++t) { const bf16x8 a = *(const bf16x8*)(vbase + voff + t * 4096); acc[t] = MFMA32(a, P, acc[t]); }
        }
    }
    float sum = 0.f, sq = 0.f;
#pragma unroll
    for (int t = 0; t < 2; ++t)
#pragma unroll
        for (int r = 0; r < 16; ++r) { const float x = acc[t][r]; sum += x; sq += x * x; }
    sum = xhalf_sum(sum); sq = xhalf_sum(sq);
    LAS f32x2* part = (LAS f32x2*)lds;
    __syncthreads();
    if (hh == 0) part[w * 32 + l31] = (f32x2){sum, sq};
    __syncthreads();
    sum = 0.f; sq = 0.f;
#pragma unroll
    for (int j = 0; j < 4; ++j) { const f32x2 v = part[(qh + 2 * j) * 32 + l31]; sum += v.x; sq += v.y; }
    const float mean = sum * (1.0f / 256.0f);
    const float rstd = rsqrtf(fmaxf(sq * (1.0f / 256.0f) - mean * mean, 0.f) + 1e-6f);
    const size_t orow = (size_t)(rowbase + l) * 1024 + h * 256 + dq * 64;
#pragma unroll
    for (int t = 0; t < 2; ++t) {
        f32x4 gwv[4]; u32x2 gtv[4];
#pragma unroll
        for (int g = 0; g < 4; ++g) { const int dv0 = t * 32 + 8 * g + 4 * hh; gwv[g] = *(const f32x4*)(p.gn + h * 256 + dq * 64 + dv0); gtv[g] = *(const u32x2*)(srg + orow + dv0); }
#pragma unroll
        for (int g = 0; g < 4; ++g) {
            const int dv0 = t * 32 + 8 * g + 4 * hh;
            const f32x4 gt = unpk4_(gtv[g]);
            f32x4 o;
#pragma unroll
            for (int j = 0; j < 4; ++j) o[j] = (acc[t][4 * g + j] - mean) * rstd * gwv[g][j] * gt[j];
            *(u32x2*)(retin + orow + dv0) = pk4(o);
        }
    }
}
DI void phase4_r3s(const Params& p, LAS unsigned char* lds) {
    for (int s = blockIdx.x; s < 32; s += gridDim.x) r3_sample_unit(p, s, lds);
}
DI void phase4_r3(const Params& p) {
    int tid = threadIdx.x; asm volatile("" : "+v"(tid));
    const int lane = tid & 63, w = __builtin_amdgcn_readfirstlane(tid >> 6), l31 = lane & 31, hh = lane >> 5;
    const bf16_t* rq = (const bf16_t*)(p.ws + OFF_RQ);
    const bf16_t* rk = (const bf16_t*)(p.ws + OFF_RK);
    const bf16_t* rvt = (const bf16_t*)(p.ws + OFF_RVT);
    const bf16_t* srg = (const bf16_t*)(p.ws + OFF_SRG);
    bf16_t* retin = (bf16_t*)(p.ws + OFF_RETIN);
    const bf16_t* kvst = (const bf16_t*)p.out;
    const bf16_t* ss = (const bf16_t*)(p.out + O_YS);
    const int nold = ((const int*)(p.ws + OFF_CTR))[40];
    for (int u = blockIdx.x; u < 256 + nold; u += gridDim.x) {
        int h, qh, rowbase; const bf16_t *stp, *vt; size_t ts;
        if (u < 256) { const int bh = u >> 5, c = (u & 31) * 4 + (w >> 1); qh = w & 1; h = bh & 3; rowbase = (bh >> 2) * 8192 + c * 64;
            stp = kvst + (size_t)(bh * 128 + c) * 32768; vt = rvt + (size_t)(bh * 128 + c) * 16384; ts = 64; }
        else { const int s = u - 256; if (w >= 2) continue; qh = w; h = s & 3; rowbase = TP + (s >> 2) * 64;
            stp = ss + (size_t)s * 32768; vt = rvt + RVT_S + (size_t)s * 16384; ts = 64; }
        const int l = qh * 32 + l31;
        const float lg = lg2gamma(h);
        const char* qbase = (const char*)(rq + (size_t)(rowbase + qh * 32) * 512 + h * 128);
        const unsigned qoff = (unsigned)(l31 * 512 + hh * 8) * 2u;
        f32x16 acc[8];
#pragma unroll
        for (int i = 0; i < 8; ++i) acc[i] = zero16();
        const unsigned soff = (unsigned)(l31 * 128 + hh * 8) * 2u;
#pragma unroll
        for (int ks = 0; ks < 8; ++ks) {
            const bf16x8 bq = *(const bf16x8*)(qbase + qoff + ks * 32);
#pragma unroll
            for (int dvt = 0; dvt < 8; ++dvt) {
                const bf16x8 a = *(const bf16x8*)((const char*)stp + soff + dvt * 8192 + ks * 32);
                acc[dvt] = MFMA32(a, bq, acc[dvt]);
            }
        }
        const float qd = fexp2((float)(l + 1) * lg);
#pragma unroll
        for (int dvt = 0; dvt < 8; ++dvt) acc[dvt] *= qd;
        const unsigned voff = (unsigned)(l31 * (unsigned)ts + hh * 8) * 2u;
        const unsigned vstep = (unsigned)ts * 64u;
        const unsigned koff = (unsigned)(pi32(l31) * 512 + hh * 8) * 2u;
        for (int kt = 0; kt <= qh; ++kt) {
            f32x16 s = zero16();
            const char* kbase = (const char*)(rk + (size_t)(rowbase + kt * 32) * 512 + h * 128);
#pragma unroll
            for (int ks = 0; ks < 8; ++ks) { const bf16x8 a = *(const bf16x8*)(kbase + koff + ks * 32); const bf16x8 bq = *(const bf16x8*)(qbase + qoff + ks * 32); s = MFMA32(a, bq, s); }
#pragma unroll
            for (int st = 0; st < 2; ++st) {
                float v[8];
#pragma unroll
                for (int j = 0; j < 8; ++j) {
                    const int reg = 8 * st + j, m = kt * 32 + pi32(crow(reg, hh)), d = l - m;
                    v[j] = d >= 0 ? s[reg] * fexp2((float)d * lg) : 0.f;
                }
                const bf16x8 P = pack8(v);
                const char* vbase = (const char*)vt + (kt * 2 + st) * 32;
#pragma unroll
                for (int dvt = 0; dvt < 8; ++dvt) {
                    const bf16x8 a = *(const bf16x8*)(vbase + voff + dvt * vstep);
                    acc[dvt] = MFMA32(a, P, acc[dvt]);
                }
            }
        }
        float sum = 0.f, sq = 0.f;
#pragma unroll
        for (int dvt = 0; dvt < 8; ++dvt)
#pragma unroll
            for (int r = 0; r < 16; ++r) { const float x = acc[dvt][r]; sum += x; sq += x * x; }
        sum = xhalf_sum(sum); sq = xhalf_sum(sq);
        const float mean = sum * (1.0f / 256.0f);
        const float rstd = rsqrtf(fmaxf(sq * (1.0f / 256.0f) - mean * mean, 0.f) + 1e-6f);
        const size_t orow = (size_t)(rowbase + l) * 1024 + h * 256;
#pragma unroll
        for (int dvt = 0; dvt < 8; ++dvt) {
            f32x4 gwv[4]; u32x2 gtv[4];
#pragma unroll
            for (int g = 0; g < 4; ++g) { const int dv0 = dvt * 32 + 8 * g + 4 * hh; gwv[g] = *(const f32x4*)(p.gn + h * 256 + dv0); gtv[g] = *(const u32x2*)(srg + orow + dv0); }
#pragma unroll
            for (int g = 0; g < 4; ++g) {
                const int dv0 = dvt * 32 + 8 * g + 4 * hh;
                const f32x4 gw = gwv[g];
                const u32x2 gt = gtv[g];
                f32x4 o;
                o[0] = (acc[dvt][4 * g + 0] - mean) * rstd * gw[0] * __uint_as_float(gt.x << 16);
                o[1] = (acc[dvt][4 * g + 1] - mean) * rstd * gw[1] * __uint_as_float(gt.x & 0xffff0000u);
                o[2] = (acc[dvt][4 * g + 2] - mean) * rstd * gw[2] * __uint_as_float(gt.y << 16);
                o[3] = (acc[dvt][4 * g + 3] - mean) * rstd * gw[3] * __uint_as_float(gt.y & 0xffff0000u);
                *(u32x2*)(retin + orow + dv0) = pk4(o);
            }
        }
    }
}

DI void epi_q(const Params& p, const f32x4 (&acc)[2][2][4][2], int pm, int tc) {
    EPI_IDS;
    bf16_t* q = (bf16_t*)(p.ws + OFF_Q);
    const float QS = 0.07216878364870322f * 1.4426950408889634f;
    const int row0 = pm * 256 + wr * 64 + fr;
    if (tc < 4) {
#pragma unroll
        for (int ai = 0; ai < 2; ++ai)
#pragma unroll
            for (int m = 0; m < 4; ++m) {
                const int row = row0 + ai * 128 + m * 16;
#pragma unroll
                for (int bj = 0; bj < 2; ++bj)
#pragma unroll
                    for (int n = 0; n < 2; ++n) {
                        const int d = wc * 32 + n * 16 + fq * 4, head = 2 * tc + bj;
                        *(u32x2*)(q + (size_t)row * 1536 + head * 192 + d) = pk4(acc[ai][bj][m][n] * QS);
                    }
            }
    } else {
#pragma unroll
        for (int ai = 0; ai < 2; ++ai)
#pragma unroll
            for (int m = 0; m < 4; ++m) {
                const int row = row0 + ai * 128 + m * 16;
                const RowInfo ri = rinfo(row);
#pragma unroll
                for (int n = 0; n < 2; ++n) {
                    const int i0 = n * 16 + fq * 4, head = 4 * (tc - 4) + wc;
                    const f32x4 x1 = acc[ai][0][m][n], x2 = acc[ai][1][m][n];
                    f32x4 o1, o2;
#pragma unroll
                    for (int j = 0; j < 4; ++j) { float c, s; rope_cs(ri.pos, 2 * (i0 + j), c, s); o1[j] = (x1[j] * c - x2[j] * s) * QS; o2[j] = (x1[j] * s + x2[j] * c) * QS; }
                    *(u32x2*)(q + (size_t)row * 1536 + head * 192 + 128 + i0) = pk4(o1);
                    *(u32x2*)(q + (size_t)row * 1536 + head * 192 + 160 + i0) = pk4(o2);
                }
            }
    }
}
DI void epi_kv(const Params& p, const f32x4 (&acc)[2][2][4][2], int pm, int tc) {
    EPI_IDS;
    bf16_t* knp = (bf16_t*)p.out;
    bf16_t* kns = (bf16_t*)(p.ws + OFF_KNS);
    const int row0 = pm * 256 + wr * 64 + fr;
#pragma unroll
    for (int ai = 0; ai < 2; ++ai)
#pragma unroll
        for (int m = 0; m < 4; ++m) {
            const int row = row0 + ai * 128 + m * 16;
            int isS, b, t;
            if (row < TP) { isS = 0; b = row >> 13; t = row & 8191; } else { const int r = row - TP; isS = 1; b = r / 2112; t = r - b * 2112; }
#pragma unroll
            for (int bj = 0; bj < 2; ++bj) {
                const int head = 2 * tc + bj;
#pragma unroll
                for (int n = 0; n < 2; ++n) {
                    const int d = wc * 32 + n * 16 + fq * 4;
                    bf16_t* dst = isS ? kns + ((size_t)(b * 8 + head) * 2112 + t) * 128 + d : knp + ((size_t)(b * 8 + head) * 8192 + t) * 128 + d;
                    *(u32x2*)dst = pk4(acc[ai][bj][m][n]);
                }
            }
        }
}
DI void epi_vT(const Params& p, const f32x4 (&acc)[2][2][4][2], int pm, int tc) {
    EPI_IDS;
    bf16_t* vtp = (bf16_t*)p.out + SZ_KNP / 2;
    bf16_t* vts = (bf16_t*)(p.ws + OFF_VTS);
#pragma unroll
    for (int bj = 0; bj < 2; ++bj)
#pragma unroll
        for (int n = 0; n < 2; ++n) {
            const int tok0 = pm * 256 + bj * 128 + wc * 32 + n * 16 + fq * 4;
#pragma unroll
            for (int ai = 0; ai < 2; ++ai) {
                const int head = 2 * (tc - 4) + ai;
                bf16_t* dst;
                if (tok0 < TP) { const int b = tok0 >> 13, t = tok0 & 8191; dst = vtp + ((size_t)(b * 8 + head) * 128 + (t >> 6)) * 8192 + (t & 63); }
                else { const int r = tok0 - TP, b = r / 2112, t = r - b * 2112; dst = vts + ((size_t)(b * 8 + head) * 33 + (t >> 6)) * 8192 + (t & 63); }
#pragma unroll
                for (int m = 0; m < 4; ++m) *(u32x2*)(dst + (wr * 64 + m * 16 + fr) * 64) = pk4(acc[ai][bj][m][n]);
            }
        }
}
struct SchedTiles {
    const bf16_t* A; const bf16_t* Bt; int lda, ldb, nM, nN, pn0, boff;
    DI bool next(int i, GUnit& u) const {
        int pm, pn; if (!tile_order((int)((blockIdx.x + boff) % gridDim.x) + i * gridDim.x, nM, nN, pm, pn)) return false;
        u.pm = pm; u.pn = pn + pn0; u.a = A + (size_t)pm * 256 * lda; u.b = Bt + (size_t)(pn + pn0) * 256 * ldb; return true;
    }
};
struct SchedKV {
    const bf16_t* X; const bf16_t* W;
    DI bool next(int i, GUnit& u) const {
        int pm, pn; if (!tile_order(blockIdx.x + i * gridDim.x, 130, 8, pm, pn)) return false;
        u.pm = pm; u.pn = pn;
        if (pn < 4) { u.a = X + (size_t)pm * 256 * 256; u.b = W + (size_t)pn * 256 * 256; }
        else { u.a = W + (size_t)pn * 256 * 256; u.b = X + (size_t)pm * 256 * 256; }
        return true;
    }
};
struct EpiKV {
    Params p;
    DI void operator()(const f32x4 (&acc)[2][2][4][2], const GUnit& u) const { if (u.pn < 4) epi_kv(p, acc, u.pm, u.pn); else epi_vT(p, acc, u.pm, u.pn); }
};
struct EpiQ {
    Params p;
    DI void operator()(const f32x4 (&acc)[2][2][4][2], const GUnit& u) const { epi_q(p, acc, u.pm, u.pn); }
};
DI void phase5_gemms(const Params& p, LAS unsigned char* shm) {
    {
        const SchedKV S{(const bf16_t*)(p.ws + OFF_CKVALL), (const bf16_t*)(p.ws + OFF_WUKV)};
        const EpiKV E{p};
        gemm_stream(shm, 256, false, 256, 4, S, E);
    }
    {
        const SchedTiles S{(const bf16_t*)(p.ws + OFF_CQ), (const bf16_t*)(p.ws + OFF_WUQ), 512, 512, 66, 6, 0, 140};
        const EpiQ E{p};
        gemm_stream(shm, 512, false, 512, 8, S, E);
    }
}

DI void phase6_attn(const Params& p, LAS unsigned char* lds, int cidx = 0) {
    int tid = threadIdx.x; asm volatile("" : "+v"(tid));
    const int lane = tid & 63, w = __builtin_amdgcn_readfirstlane(tid >> 6), l31 = lane & 31, hh = lane >> 5;
    unsigned* ctr = (unsigned*)(p.ws + OFF_CTR) + cidx;
    const bool dostore = ((const unsigned*)(p.ws + OFF_CTR))[32 + cidx] == 0u;
    bf16_t* q = (bf16_t*)(p.ws + OFF_Q);
    const bf16_t* knp = (const bf16_t*)p.out; const bf16_t* vtp = knp + SZ_KNP / 2;
    const bf16_t* kns = (const bf16_t*)(p.ws + OFF_KNS); const bf16_t* vts = (const bf16_t*)(p.ws + OFF_VTS);
    const bf16_t* kpeall = (const bf16_t*)(p.ws + OFF_KPEALL);
    constexpr int TBUF = 40960, KPO = 16384, VO = 24576, UOFF = 3 * TBUF;
    for (;;) {
        if (tid == 0) *(LAS unsigned*)(lds + UOFF) = atomicAdd(ctr, 1u);
        __syncthreads();
        const int u = (int)*(LAS unsigned*)(lds + UOFF);
        __syncthreads();
        if (u >= 576) break;
        const int uu = u < 368 ? u : (u < 432 ? 512 + (u - 368) : u - 64);
        int h, rowq0, nkt, limit; bool active; const bf16_t *kn, *kpe, *vt;
        if (uu < 512) { const int qb = 31 - (uu >> 4), bh = uu & 15, b = bh >> 3; h = bh & 7; rowq0 = b * 8192 + qb * 256; nkt = 4 * qb + 4; limit = 4 * qb + (w >> 1); active = true;
            kn = knp + (size_t)bh * 8192 * 128; kpe = kpeall + (size_t)b * 8192 * 64; vt = vtp + (size_t)bh * 128 * 8192; }
        else { const int su = uu - 512, b = su >> 3; h = su & 7; rowq0 = TP + b * 64; nkt = 33; limit = 32; active = w < 2;
            kn = kns + (size_t)su * 2112 * 128; kpe = kpeall + (size_t)(TP + b * 2112) * 64; vt = vts + (size_t)su * 33 * 8192; }
        bf16x8 Bq[12];
        bf16_t* qrow = q + (size_t)(rowq0 + 32 * w + l31) * 1536 + h * 192;
        if (active) {
#pragma unroll
            for (int ks = 0; ks < 12; ++ks) Bq[ks] = *(const bf16x8*)(qrow + ks * 16 + hh * 8);
        } else {
#pragma unroll
            for (int ks = 0; ks < 12; ++ks) Bq[ks] = (bf16x8){0, 0, 0, 0, 0, 0, 0, 0};
        }
        f32x16 o[4];
#pragma unroll
        for (int i = 0; i < 4; ++i) o[i] = zero16();
        float mrun = -INFINITY, lsum = 0.f;
        unsigned gk[2], gp, gv[2];
#pragma unroll
        for (int i = 0; i < 2; ++i) {
            const int rowk = 4 * (2 * w + i) + (lane >> 4), sl = lane & 15;
            gk[i] = (unsigned)(rowk * 128 + ((sl ^ (rowk & 15)) * 8));
            const int rowv = 8 * (2 * w + i) + (lane >> 3), sv = lane & 7;
            gv[i] = (unsigned)(rowv * 64 + ((sv ^ ((rowv >> 1) & 7)) * 8));
        }
        { const int rowp = 8 * w + (lane >> 3), sp = lane & 7; gp = (unsigned)(rowp * 64 + ((sp ^ ((rowp >> 1) & 7)) * 8)); }
#define ATT_GLDS(boff, kt) do { \
            __builtin_amdgcn_global_load_lds((const unsigned*)(kn + (size_t)(kt) * 8192 + gk[0]), (LAS unsigned*)(lds + (boff) + (2 * w) * 1024), 16, 0, 0); \
            __builtin_amdgcn_global_load_lds((const unsigned*)(kn + (size_t)(kt) * 8192 + gk[1]), (LAS unsigned*)(lds + (boff) + (2 * w + 1) * 1024), 16, 0, 0); \
            __builtin_amdgcn_global_load_lds((const unsigned*)(kpe + (size_t)(kt) * 4096 + gp), (LAS unsigned*)(lds + (boff) + KPO + w * 1024), 16, 0, 0); \
            __builtin_amdgcn_global_load_lds((const unsigned*)(vt + (size_t)(kt) * 8192 + gv[0]), (LAS unsigned*)(lds + (boff) + VO + (2 * w) * 1024), 16, 0, 0); \
            __builtin_amdgcn_global_load_lds((const unsigned*)(vt + (size_t)(kt) * 8192 + gv[1]), (LAS unsigned*)(lds + (boff) + VO + (2 * w + 1) * 1024), 16, 0, 0); } while (0)
        const int krow = pi32(l31);
        unsigned ka[12], va[4];
#pragma unroll
        for (int ks = 0; ks < 8; ++ks) ka[ks] = (unsigned)(krow * 256 + (((ks * 2 + hh) ^ (krow & 15)) * 16));
#pragma unroll
        for (int ks = 8; ks < 12; ++ks) ka[ks] = (unsigned)(KPO + krow * 128 + ((((ks - 8) * 2 + hh) ^ ((krow >> 1) & 7)) * 16));
#pragma unroll
        for (int kk = 0; kk < 4; ++kk) va[kk] = (unsigned)(VO + l31 * 128 + (((kk * 2 + hh) ^ ((l31 >> 1) & 7)) * 16));
        ATT_GLDS(0, 0);
        if (nkt > 1) { ATT_GLDS(TBUF, 1); asm volatile("s_waitcnt vmcnt(5)" ::: "memory"); }
        else asm volatile("s_waitcnt vmcnt(0)" ::: "memory");
        __syncthreads();
        int boff = 0, bnn = 2 * TBUF;
        for (int kt = 0; kt < nkt; ++kt) {
            const bool more = kt + 2 < nkt;
            if (more) ATT_GLDS(bnn, kt + 2);
            if (active && kt <= limit) {
                const LAS unsigned char* tb = lds + boff;
#define KFR(sub, ks) (*(const LAS bf16x8*)(tb + ka[ks] + (sub) * 32 * ((ks) < 8 ? 256 : 128)))
#define VFR(f) (*(const LAS bf16x8*)(tb + va[(f) & 3] + ((f) >> 2) * 32 * 128))
#define SBAR __builtin_amdgcn_sched_barrier(0)
                bf16x8 fa[4], fb[4];
                f32x16 s[2]; s[0] = zero16(); s[1] = zero16();
#pragma unroll
                for (int i = 0; i < 4; ++i) fa[i] = KFR(0, i);
                SBAR;
#pragma unroll
                for (int i = 0; i < 4; ++i) { fb[i] = KFR(0, 4 + i); s[0] = MFMA32(fa[i], Bq[i], s[0]); }
                SBAR;
#pragma unroll
                for (int i = 0; i < 4; ++i) { fa[i] = KFR(0, 8 + i); s[0] = MFMA32(fb[i], Bq[4 + i], s[0]); }
                SBAR;
#pragma unroll
                for (int i = 0; i < 4; ++i) { fb[i] = KFR(1, i); s[0] = MFMA32(fa[i], Bq[8 + i], s[0]); }
                SBAR;
#pragma unroll
                for (int i = 0; i < 4; ++i) { fa[i] = KFR(1, 4 + i); s[1] = MFMA32(fb[i], Bq[i], s[1]); }
                SBAR;
#pragma unroll
                for (int i = 0; i < 4; ++i) { fb[i] = KFR(1, 8 + i); s[1] = MFMA32(fa[i], Bq[4 + i], s[1]); }
                SBAR;
#pragma unroll
                for (int i = 0; i < 4; ++i) { fa[i] = VFR(i); s[1] = MFMA32(fb[i], Bq[8 + i], s[1]); }
                SBAR;
                float mx = s[0][0];
#pragma unroll
                for (int r = 0; r < 16; ++r) { mx = fmaxf(mx, s[0][r]); mx = fmaxf(mx, s[1][r]); }
                mx = xhalf_max(mx);
                if (__builtin_amdgcn_ballot_w64(mx > mrun + 8.0f) != 0ull) {
                    const float mnew = mx > mrun + 8.0f ? mx : mrun;
                    const float alpha = fexp2(mrun - mnew);
                    mrun = mnew;
                    lsum *= alpha;
#pragma unroll
                    for (int dvt = 0; dvt < 4; ++dvt) o[dvt] *= alpha;
                }
                const float mnew = mrun;
                float ps = 0.f;
                bf16x8 P[4];
#pragma unroll
                for (int i = 0; i < 4; ++i) fb[i] = VFR(4 + i);
#pragma unroll
                for (int sub = 0; sub < 2; ++sub)
#pragma unroll
                    for (int st = 0; st < 2; ++st) {
                        float v[8];
#pragma unroll
                        for (int j = 0; j < 8; ++j) { v[j] = fexp2(s[sub][8 * st + j] - mnew); ps += v[j]; }
                        P[sub * 2 + st] = pack8(v);
                    }
                lsum += ps;
                SBAR;
#pragma unroll
                for (int i = 0; i < 4; ++i) o[0] = MFMA32(fa[i], P[i], o[0]);
                SBAR;
#pragma unroll
                for (int i = 0; i < 4; ++i) { fa[i] = VFR(8 + i); o[1] = MFMA32(fb[i], P[i], o[1]); }
                SBAR;
#pragma unroll
                for (int i = 0; i < 4; ++i) { fb[i] = VFR(12 + i); o[2] = MFMA32(fa[i], P[i], o[2]); }
                SBAR;
#pragma unroll
                for (int i = 0; i < 4; ++i) o[3] = MFMA32(fb[i], P[i], o[3]);
            }
            if (more) asm volatile("s_waitcnt vmcnt(5)" ::: "memory"); else asm volatile("s_waitcnt vmcnt(0)" ::: "memory");
            __syncthreads();
            { const int nb = boff + TBUF >= 3 * TBUF ? 0 : boff + TBUF; bnn = boff; boff = nb; }
        }
        if (active && dostore) {
            const float ltot = xhalf_sum(lsum);
            const float inv = 1.0f / ltot;
#pragma unroll
            for (int dvt = 0; dvt < 4; ++dvt)
#pragma unroll
                for (int g4 = 0; g4 < 4; ++g4) {
                    f32x4 v; v[0] = o[dvt][4 * g4] * inv; v[1] = o[dvt][4 * g4 + 1] * inv; v[2] = o[dvt][4 * g4 + 2] * inv; v[3] = o[dvt][4 * g4 + 3] * inv;
                    *(u32x2*)(qrow + dvt * 32 + 8 * g4 + 4 * hh) = pk4(v);
                }
        }
    }
}

template <int PASS>
DI void phase8_pass(const Params& p, LAS unsigned char* shm) {
    const bf16_t* sg = (const bf16_t*)(p.ws + (PASS == 0 ? OFF_SGA : OFF_SGB));
    bf16_t* merged = (bf16_t*)(p.ws + OFF_MERGED);
    for (int L = blockIdx.x;; L += gridDim.x) {
        int pm, pn; if (!tile_order(L, 64, 4, pm, pn)) break;
        f32x4 acc[2][2][4][2]; ZERO_ACC(acc);
        if (PASS == 0) gemm_kloop(acc, (const bf16_t*)(p.ws + OFF_RETIN), 1024, false, (const bf16_t*)(p.ws + OFF_WRO), 1024, 16, pm * 256, pn * 256, shm);
        else gemm_kloop(acc, (const bf16_t*)(p.ws + OFF_Q), 1536, true, (const bf16_t*)(p.ws + OFF_WMO), 1024, 16, pm * 256, pn * 256, shm);
        EPI_IDS;
        const int row0 = pm * 256 + wr * 64 + fr;
#pragma unroll
        for (int ai = 0; ai < 2; ++ai)
#pragma unroll
            for (int mp = 0; mp < 2; ++mp) {
                u32x2 gb[2][2][2], tb[2][2][2];
#pragma unroll
                for (int mm = 0; mm < 2; ++mm) {
                    const size_t rbase = (size_t)(row0 + ai * 128 + (mp * 2 + mm) * 16) * 1024 + pn * 256 + wc * 32 + fq * 4;
#pragma unroll
                    for (int bj = 0; bj < 2; ++bj)
#pragma unroll
                        for (int n = 0; n < 2; ++n) {
                            gb[mm][bj][n] = *(const u32x2*)(sg + rbase + bj * 128 + n * 16);
                            if (PASS == 1) tb[mm][bj][n] = *(const u32x2*)(merged + rbase + bj * 128 + n * 16);
                        }
                }
#pragma unroll
                for (int mm = 0; mm < 2; ++mm) {
                    const int m = mp * 2 + mm;
                    const size_t rbase = (size_t)(row0 + ai * 128 + m * 16) * 1024 + pn * 256 + wc * 32 + fq * 4;
#pragma unroll
                    for (int bj = 0; bj < 2; ++bj)
#pragma unroll
                        for (int n = 0; n < 2; ++n) {
                            const u32x2 b = gb[mm][bj][n];
                            f32x4 r; r[0] = __uint_as_float(b.x << 16); r[1] = __uint_as_float(b.x & 0xffff0000u); r[2] = __uint_as_float(b.y << 16); r[3] = __uint_as_float(b.y & 0xffff0000u);
                            f32x4 o = acc[ai][bj][m][n] * r;
                            if (PASS == 1) {
                                const u32x2 t = tb[mm][bj][n];
                                o[0] += __uint_as_float(t.x << 16); o[1] += __uint_as_float(t.x & 0xffff0000u); o[2] += __uint_as_float(t.y << 16); o[3] += __uint_as_float(t.y & 0xffff0000u);
                            }
                            *(u32x2*)(merged + rbase + bj * 128 + n * 16) = pk4(o);
                        }
                }
            }
    }
}
DI void phase8_merge(const Params& p, LAS unsigned char* shm) { phase8_pass<0>(p, shm); phase8_pass<1>(p, shm); }
DI float* hrow(const Params& p, int row) { return row < TP ? p.out + O_YP + (size_t)row * 1024 : p.out + O_YS + (size_t)(row - TP) * 1024; }
DI void phase9_out(const Params& p, LAS unsigned char* shm) {
    for (int L = blockIdx.x;; L += gridDim.x) {
        int pm, pn; if (!tile_order(L, 64, 4, pm, pn)) break;
        f32x4 acc[2][2][4][2]; ZERO_ACC(acc);
        gemm_kloop(acc, (const bf16_t*)(p.ws + OFF_MERGED), 1024, false, (const bf16_t*)(p.ws + OFF_WOUT), 1024, 16, pm * 256, pn * 256, shm);
        EPI_IDS;
        const int row0 = pm * 256 + wr * 64 + fr;
        const int cb = pn * 256 + wc * 32 + fq * 4;
        f32x4 gv[2][2];
#pragma unroll
        for (int bj = 0; bj < 2; ++bj)
#pragma unroll
            for (int n = 0; n < 2; ++n) gv[bj][n] = *(const f32x4*)(p.nffn + cb + bj * 128 + n * 16);
#pragma unroll
        for (int ai = 0; ai < 2; ++ai)
#pragma unroll
            for (int mp = 0; mp < 2; ++mp) {
                f32x4 xv[2][2][2];
#pragma unroll
                for (int mm = 0; mm < 2; ++mm) {
                    const int row = row0 + ai * 128 + (mp * 2 + mm) * 16;
                    const float* xr = row < TP ? p.x_p + (size_t)row * 1024 : p.x_s + (size_t)(row - TP) * 1024;
#pragma unroll
                    for (int bj = 0; bj < 2; ++bj)
#pragma unroll
                        for (int n = 0; n < 2; ++n) xv[mm][bj][n] = *(const f32x4*)(xr + cb + bj * 128 + n * 16);
                }
#pragma unroll
                for (int mm = 0; mm < 2; ++mm) {
                    const int m = mp * 2 + mm, row = row0 + ai * 128 + m * 16;
                    float* hr = hrow(p, row);
                    bf16_t* hb = (bf16_t*)(p.ws + OFF_HN) + (size_t)row * 1024;
                    float ss = 0.f;
#pragma unroll
                    for (int bj = 0; bj < 2; ++bj)
#pragma unroll
                        for (int n = 0; n < 2; ++n) {
                            const int c = cb + bj * 128 + n * 16;
                            const f32x4 hv = xv[mm][bj][n] + acc[ai][bj][m][n];
                            *(f32x4*)(hr + c) = hv;
                            *(u32x2*)(hb + c) = pk4(hv * gv[bj][n]);
                            ss += hv[0] * hv[0] + hv[1] * hv[1] + hv[2] * hv[2] + hv[3] * hv[3];
                        }
                    ss += __shfl_xor(ss, 16); ss += __shfl_xor(ss, 32);
                    if (fq == 0) atomicAdd((float*)(p.ws + OFF_ROWSS) + row, ss);
                }
            }
    }
}
DI void phase10_hn(const Params& p) {
    const int gtid = blockIdx.x * NTHREADS + threadIdx.x, nth = gridDim.x * NTHREADS;
    const int gw = gtid >> 6, nw = nth >> 6, lane = threadIdx.x & 63;
    bf16_t* hn = (bf16_t*)(p.ws + OFF_HN);
    for (int row = gw; row < TALL; row += 2 * nw) {
        const int row2 = row + nw;
        if (row2 < TALL) rmsnorm_row2_1024(hrow(p, row), hrow(p, row2), p.nffn, hn + (size_t)row * 1024, hn + (size_t)row2 * 1024, lane);
        else rmsnorm_row_1024(hrow(p, row), p.nffn, hn + (size_t)row * 1024, lane);
    }
}
struct EpiGU {
    Params p;
    DI void operator()(const f32x4 (&acc)[2][2][4][2], const GUnit& u) const {
        EPI_IDS;
        bf16_t* act = (bf16_t*)(p.ws + OFF_ACT);
        const int row0 = u.pm * 256 + wr * 64 + fr;
        float rss[2][4];
#pragma unroll
        for (int ai = 0; ai < 2; ++ai)
#pragma unroll
            for (int m = 0; m < 4; ++m) rss[ai][m] = ((const float*)(p.ws + OFF_ROWSS))[row0 + ai * 128 + m * 16];
#pragma unroll
        for (int ai = 0; ai < 2; ++ai)
#pragma unroll
            for (int m = 0; m < 4; ++m) {
                const float rstd = rsqrtf(rss[ai][m] * (1.0f / 1024.0f) + 1e-6f);
#pragma unroll
                for (int n = 0; n < 2; ++n) {
                    const f32x4 g = acc[ai][0][m][n] * rstd, uu = acc[ai][1][m][n] * rstd;
                    f32x4 o;
#pragma unroll
                    for (int j = 0; j < 4; ++j) o[j] = siluf_(g[j]) * uu[j];
                    *(u32x2*)(act + (size_t)(row0 + ai * 128 + m * 16) * 2816 + u.pn * 128 + wc * 32 + n * 16 + fq * 4) = pk4(o);
                }
            }
    }
};
DI void phase11_gu(const Params& p, LAS unsigned char* shm) {
    const SchedTiles S{(const bf16_t*)(p.ws + OFF_HN), (const bf16_t*)(p.ws + OFF_WGU), 1024, 1024, 66, 22, 0, 0};
    const EpiGU E{p};
    gemm_stream(shm, 1024, false, 1024, 16, S, E);
}
DI unsigned xb_ld(unsigned* p);
DI unsigned xb_add(unsigned* p, unsigned v);
DI void phase12_down(const Params& p, LAS unsigned char* shm, bool fused) {
    for (int L = blockIdx.x;; L += gridDim.x) {
        int pm, pn; if (!tile_order(L, 64, 4, pm, pn)) break;
        f32x4 acc[2][2][4][2]; ZERO_ACC(acc);
        gemm_kloop(acc, (const bf16_t*)(p.ws + OFF_ACT), 2816, false, (const bf16_t*)(p.ws + OFF_WDN), 2816, 44, pm * 256, pn * 256, shm);
        EPI_IDS;
        const int tid = wid * 64 + lane;
        const int row0 = pm * 256 + wr * 64 + fr;
        const int cb = pn * 256 + wc * 32 + fq * 4;
        float ssr[2][4];
#pragma unroll
        for (int ai = 0; ai < 2; ++ai)
#pragma unroll
            for (int mp = 0; mp < 2; ++mp) {
                f32x4 hv[2][2][2];
#pragma unroll
                for (int mm = 0; mm < 2; ++mm) {
                    const float* hr = hrow(p, row0 + ai * 128 + (mp * 2 + mm) * 16);
#pragma unroll
                    for (int bj = 0; bj < 2; ++bj)
#pragma unroll
                        for (int n = 0; n < 2; ++n) hv[mm][bj][n] = *(const f32x4*)(hr + cb + bj * 128 + n * 16);
                }
#pragma unroll
                for (int mm = 0; mm < 2; ++mm) {
                    const int m = mp * 2 + mm;
                    float ss = 0.f;
#pragma unroll
                    for (int bj = 0; bj < 2; ++bj)
#pragma unroll
                        for (int n = 0; n < 2; ++n) {
                            const f32x4 v = hv[mm][bj][n] + acc[ai][bj][m][n];
                            acc[ai][bj][m][n] = v;
                            ss += v[0] * v[0] + v[1] * v[1] + v[2] * v[2] + v[3] * v[3];
                        }
                    ss += __shfl_xor(ss, 16); ss += __shfl_xor(ss, 32);
                    ssr[ai][m] = ss;
                }
            }
        if (!fused) {
#pragma unroll
            for (int ai = 0; ai < 2; ++ai)
#pragma unroll
                for (int m = 0; m < 4; ++m) {
                    float* hr = hrow(p, row0 + ai * 128 + m * 16);
#pragma unroll
                    for (int bj = 0; bj < 2; ++bj)
#pragma unroll
                        for (int n = 0; n < 2; ++n) *(f32x4*)(hr + cb + bj * 128 + n * 16) = acc[ai][bj][m][n];
                }
            continue;
        }
        LAS float* part = (LAS float*)shm;
        LAS float* rst = part + 1024;
        __syncthreads();
        if (fq == 0) {
#pragma unroll
            for (int ai = 0; ai < 2; ++ai)
#pragma unroll
                for (int m = 0; m < 4; ++m) part[wc * 256 + ai * 128 + wr * 64 + m * 16 + fr] = ssr[ai][m];
        }
        __syncthreads();
        float* xbuf = (float*)(p.ws + OFF_XBUF) + (size_t)pm * 1024;
        unsigned* cnt = (unsigned*)(p.ws + OFF_PCNT) + pm * 64;
        if (tid < 256) __hip_atomic_store(xbuf + pn * 256 + tid, part[tid] + part[256 + tid] + part[512 + tid] + part[768 + tid], __ATOMIC_RELAXED, __HIP_MEMORY_SCOPE_AGENT);
        __builtin_amdgcn_fence(__ATOMIC_RELEASE, "agent");
        asm volatile("s_waitcnt vmcnt(0)" ::: "memory");
        __syncthreads();
        if (tid == 0) {
            xb_add(cnt, 1u);
            unsigned sp = 0;
            while (xb_ld(cnt) < 4u) { __builtin_amdgcn_s_sleep(1); if (++sp > (1u << 22)) break; }
            __builtin_amdgcn_fence(__ATOMIC_ACQUIRE, "agent");
            asm volatile("s_waitcnt vmcnt(0)" ::: "memory");
        }
        __syncthreads();
        if (tid < 256) {
            float s = 0.f;
#pragma unroll
            for (int q = 0; q < 4; ++q) s += __hip_atomic_load(xbuf + q * 256 + tid, __ATOMIC_RELAXED, __HIP_MEMORY_SCOPE_AGENT);
            rst[tid] = rsqrtf(s * (1.0f / 1024.0f) + 1e-6f);
        }
        __syncthreads();
        f32x4 gv[2][2];
#pragma unroll
        for (int bj = 0; bj < 2; ++bj)
#pragma unroll
            for (int n = 0; n < 2; ++n) gv[bj][n] = *(const f32x4*)(p.nfin + cb + bj * 128 + n * 16);
#pragma unroll
        for (int ai = 0; ai < 2; ++ai)
#pragma unroll
            for (int m = 0; m < 4; ++m) {
                const float rs = rst[ai * 128 + wr * 64 + m * 16 + fr];
                float* yr = hrow(p, row0 + ai * 128 + m * 16);
#pragma unroll
                for (int bj = 0; bj < 2; ++bj)
#pragma unroll
                    for (int n = 0; n < 2; ++n) *(f32x4*)(yr + cb + bj * 128 + n * 16) = acc[ai][bj][m][n] * rs * gv[bj][n];
            }
    }
}
DI void phase13_final(const Params& p, int rowstart) {
    const int gtid = blockIdx.x * NTHREADS + threadIdx.x, nth = gridDim.x * NTHREADS;
    const int gw = gtid >> 6, nw = nth >> 6, lane = threadIdx.x & 63;
    for (int row = rowstart + gw; row < TALL; row += nw) {
        float* x = hrow(p, row);
        f32x4 v[4]; float ss = 0.f;
#pragma unroll
        for (int i = 0; i < 4; ++i) { v[i] = *(const f32x4*)(x + i * 256 + lane * 4); ss += v[i][0] * v[i][0] + v[i][1] * v[i][1] + v[i][2] * v[i][2] + v[i][3] * v[i][3]; }
        ss = wave_sum(ss);
        const float rstd = rsqrtf(ss * (1.0f / 1024.0f) + 1e-6f);
#pragma unroll
        for (int i = 0; i < 4; ++i) { const f32x4 gg = *(const f32x4*)(p.nfin + i * 256 + lane * 4); *(f32x4*)(x + i * 256 + lane * 4) = v[i] * rstd * gg; }
    }
}

DI f32x4 thin_block(const bf16_t* __restrict__ A, int lda, bool a192, const bf16_t* __restrict__ Bt, int ldb, int K, int row0, int col0, LAS unsigned char* lds) {
    int tid = threadIdx.x; asm volatile("" : "+v"(tid));
    const int lane = tid & 63, w = __builtin_amdgcn_readfirstlane(tid >> 6), l31 = lane & 31, hh = lane >> 5;
    const int kw = K >> 3;
    const int kb = w * kw, ka = a192 ? w * 192 : kb;
    const bf16_t* ap = A + (size_t)(row0 + l31) * lda + ka + hh * 8;
    const bf16_t* bp = Bt + (size_t)(col0 + l31) * ldb + kb + hh * 8;
    f32x16 acc0 = zero16(), acc1 = zero16();
    for (int k = 0; k < kw; k += 64) {
        bf16x8 a[4], b0[4], b1[4];
#pragma unroll
        for (int i = 0; i < 4; ++i) {
            const int kk = k + 16 * i;
            const bool ok = kk < kw;
            a[i] = ok ? *(const bf16x8*)(ap + kk) : (bf16x8){0, 0, 0, 0, 0, 0, 0, 0};
            b0[i] = ok ? *(const bf16x8*)(bp + kk) : (bf16x8){0, 0, 0, 0, 0, 0, 0, 0};
            b1[i] = ok ? *(const bf16x8*)(bp + (size_t)32 * ldb + kk) : (bf16x8){0, 0, 0, 0, 0, 0, 0, 0};
        }
#pragma unroll
        for (int i = 0; i < 4; ++i) { acc0 = MFMA32(a[i], b0[i], acc0); acc1 = MFMA32(a[i], b1[i], acc1); }
    }
    __syncthreads();
    LAS float* part = (LAS float*)lds;
#pragma unroll
    for (int r = 0; r < 16; ++r) {
        const int row = crow(r, hh);
        part[(w * 32 + row) * 64 + l31] = acc0[r];
        part[(w * 32 + row) * 64 + 32 + l31] = acc1[r];
    }
    __syncthreads();
    f32x4 o = {0.f, 0.f, 0.f, 0.f};
#pragma unroll
    for (int ww = 0; ww < 8; ++ww) o += *(const LAS f32x4*)(part + (ww * 32 + (tid >> 4)) * 64 + (tid & 15) * 4);
    return o;
}
template <int WHICH>
DI void thin_phase(const Params& p, LAS unsigned char* lds) {
    const int ncb = WHICH == 7 ? 32 : 16;
    for (int t = blockIdx.x; t < 16 * ncb; t += gridDim.x) {
        const int rbk = t & 15, cbk = t >> 4;
        const int row0 = TP + rbk * 32, col0 = cbk * 64;
        int tid = threadIdx.x; asm volatile("" : "+v"(tid));
        const int row = row0 + (tid >> 4), c = col0 + (tid & 15) * 4;
        if (WHICH == 7) {
            const f32x4 acc = thin_block((const bf16_t*)(p.ws + OFF_XN), 1024, false, (const bf16_t*)(p.ws + OFF_WIN) + (size_t)4096 * 1024, 1024, 1024, row0, col0, lds);
            bf16_t* dst = (bf16_t*)(p.ws + (c < 1024 ? OFF_SGA : OFF_SGB)) + (size_t)row * 1024 + (c & 1023);
            f32x4 v; for (int j = 0; j < 4; ++j) v[j] = sigmoidf_(acc[j]);
            *(u32x2*)dst = pk4(v);
        } else if (WHICH == 8) {
            const f32x4 a1 = thin_block((const bf16_t*)(p.ws + OFF_RETIN), 1024, false, (const bf16_t*)(p.ws + OFF_WRO), 1024, 1024, row0, col0, lds);
            const f32x4 a2 = thin_block((const bf16_t*)(p.ws + OFF_Q), 1536, true, (const bf16_t*)(p.ws + OFF_WMO), 1024, 1024, row0, col0, lds);
            const size_t idx = (size_t)row * 1024 + c;
            const u32x2 ga = *(const u32x2*)((const bf16_t*)(p.ws + OFF_SGA) + idx), gb = *(const u32x2*)((const bf16_t*)(p.ws + OFF_SGB) + idx);
            f32x4 o;
            o[0] = __uint_as_float(ga.x << 16) * a1[0] + __uint_as_float(gb.x << 16) * a2[0];
            o[1] = __uint_as_float(ga.x & 0xffff0000u) * a1[1] + __uint_as_float(gb.x & 0xffff0000u) * a2[1];
            o[2] = __uint_as_float(ga.y << 16) * a1[2] + __uint_as_float(gb.y << 16) * a2[2];
            o[3] = __uint_as_float(ga.y & 0xffff0000u) * a1[3] + __uint_as_float(gb.y & 0xffff0000u) * a2[3];
            *(u32x2*)((bf16_t*)(p.ws + OFF_MERGED) + idx) = pk4(o);
        } else if (WHICH == 9) {
            const f32x4 acc = thin_block((const bf16_t*)(p.ws + OFF_MERGED), 1024, false, (const bf16_t*)(p.ws + OFF_WOUT), 1024, 1024, row0, col0, lds);
            const size_t o = (size_t)(row - TP) * 1024 + c;
            const f32x4 hv = *(const f32x4*)(p.x_s + o) + acc;
            *(f32x4*)(p.out + O_YS + o) = hv;
            *(u32x2*)((bf16_t*)(p.ws + OFF_HN) + (size_t)row * 1024 + c) = pk4(hv * *(const f32x4*)(p.nffn + c));
            float ss = hv[0] * hv[0] + hv[1] * hv[1] + hv[2] * hv[2] + hv[3] * hv[3];
            ss += __shfl_xor(ss, 1); ss += __shfl_xor(ss, 2); ss += __shfl_xor(ss, 4); ss += __shfl_xor(ss, 8);
            if ((tid & 15) == 0) atomicAdd((float*)(p.ws + OFF_ROWSS) + row, ss);
        } else {
            const f32x4 acc = thin_block((const bf16_t*)(p.ws + OFF_ACT), 2816, false, (const bf16_t*)(p.ws + OFF_WDN), 2816, 2816, row0, col0, lds);
            float* hp = p.out + O_YS + (size_t)(row - TP) * 1024 + c;
            *(f32x4*)hp = *(const f32x4*)hp + acc;
        }
    }
}

#define XB_TMO      128
#define XB_XCNT(j)  (256  + 64 * (j))
#define XB_XSUB(j)  (1280 + 64 * (j))
#define XB_XGEN(j)  (2304 + 64 * (j))
#define XB_TOP      3328
#define XB_TOPGEN   3392
#define XCD_BAR_WORDS 3456
#define XB_SPIN_CAP (1u << 18)
DI unsigned xb_ld(unsigned* p) { return __hip_atomic_load(p, __ATOMIC_RELAXED, __HIP_MEMORY_SCOPE_AGENT); }
DI unsigned xb_add(unsigned* p, unsigned v) { return __hip_atomic_fetch_add(p, v, __ATOMIC_RELAXED, __HIP_MEMORY_SCOPE_AGENT); }
DI unsigned xb_xcc_id() { return (unsigned)__builtin_amdgcn_s_getreg((3 << 11) | 20) & 0xFu; }
#define XB_SPIN(cond, bar) do { unsigned _sp = 0; while (cond) { __builtin_amdgcn_s_sleep(1); \
    if ((++_sp & 255u) == 0u) { if (xb_ld(&(bar)[XB_TMO])) break; if (_sp > XB_SPIN_CAP) { atomicAdd(&(bar)[XB_TMO], 1u); break; } } } } while (0)
struct XcdBarrier { unsigned* bar; unsigned x; volatile LAS unsigned* st; };
DI XcdBarrier xcd_barrier_post(unsigned* bar, volatile LAS unsigned* st) {
    XcdBarrier b; b.bar = bar; b.x = xb_xcc_id(); b.st = st;
    if (threadIdx.x == 0) (void)xb_add(&bar[XB_XCNT(b.x)], 1u);
    return b;
}
DI void xcd_barrier_complete(unsigned* bar, unsigned x, unsigned& nloc, unsigned& nx) {
    const unsigned G = gridDim.x * gridDim.y * gridDim.z;
    unsigned sum, cnt, mine, sp = 0u;
    for (;;) {
        sum = 0u; cnt = 0u; mine = 0u;
#pragma unroll
        for (unsigned j = 0; j < 16; ++j) { const unsigned c = xb_ld(&bar[XB_XCNT(j)]); sum += c; cnt += (c > 0u) ? 1u : 0u; mine = (j == x) ? c : mine; }
        if (sum == G) break;
        __builtin_amdgcn_s_sleep(1);
        if ((++sp & 255u) == 0u) { if (xb_ld(&bar[XB_TMO])) break; if (sp > XB_SPIN_CAP) { atomicAdd(&bar[XB_TMO], 1u); break; } }
    }
    nloc = mine > 0u ? mine : 1u; nx = cnt > 0u ? cnt : 1u;
}
DI void xcd_barrier(const XcdBarrier& b) {
    asm volatile("s_waitcnt vmcnt(0)" ::: "memory");
    __syncthreads();
    if (threadIdx.x == 0) {
        unsigned* bar = b.bar;
        __builtin_amdgcn_s_waitcnt(0);
        unsigned nloc = b.st[0], nx = b.st[1];
        if (nloc == 0u) { xcd_barrier_complete(bar, b.x, nloc, nx); b.st[0] = nloc; b.st[1] = nx; }
        const unsigned old = xb_add(&bar[XB_XSUB(b.x)], 1u);
        const unsigned gen = old / nloc;
        if (old + 1u == (gen + 1u) * nloc) {
            __builtin_amdgcn_fence(__ATOMIC_RELEASE, "agent");
            asm volatile("s_waitcnt vmcnt(0)" ::: "memory");
            const unsigned og = xb_add(&bar[XB_TOP], 1u);
            const unsigned tg = og / nx;
            if (og + 1u == (tg + 1u) * nx) xb_add(&bar[XB_TOPGEN], 1u);
            else XB_SPIN(xb_ld(&bar[XB_TOPGEN]) == tg, bar);
            __builtin_amdgcn_fence(__ATOMIC_ACQUIRE, "agent");
            xb_add(&bar[XB_XGEN(b.x)], 1u);
            asm volatile("s_waitcnt vmcnt(0)" ::: "memory");
        } else {
            XB_SPIN(xb_ld(&bar[XB_XGEN(b.x)]) == gen, bar);
            __builtin_amdgcn_fence(__ATOMIC_ACQUIRE, "agent");
            asm volatile("s_waitcnt vmcnt(0)" ::: "memory");
        }
    }
    __syncthreads();
}

__global__ void __launch_bounds__(NTHREADS) fwd_megakernel(Params p) {
    extern __shared__ __attribute__((aligned(16))) unsigned char smem[];
    cg::grid_group grid = cg::this_grid();
    LAS unsigned char* shm = (LAS unsigned char*)smem;
#ifndef PMASK
#define PMASK 0xffff
#endif
#define PH(k) if ((PMASK >> (k)) & 1)
    volatile LAS unsigned* xst = (volatile LAS unsigned*)(shm + 131072);
    if (threadIdx.x == 0) { xst[0] = 0u; xst[1] = 0u; }
    __syncthreads();
    const XcdBarrier xbar = xcd_barrier_post((unsigned*)(p.ws + OFF_BAR), xst);
    if (p.ws == nullptr) grid.sync();
#define GSYNC() xcd_barrier(xbar)
#ifdef TIMING_RUN
    unsigned long long* tsb = (unsigned long long*)(p.ws + OFF_CTR + 256);
    int tsi = 0;
#define STAMP() do { if (blockIdx.x == 0 && threadIdx.x == 0) tsb[tsi] = wall_clock64(); ++tsi; } while (0)
#else
#define STAMP() do {} while (0)
#endif
    STAMP();
    PH(0) phase0(p, shm);
#if PROBE_DOUBLE == 100
    phase0(p, shm);
#endif
    GSYNC(); STAMP();
    PH(1) phase1_gemm(p, shm);
#if PROBE_DOUBLE == 1
    phase1_gemm(p, shm);
#endif
    GSYNC(); STAMP();
    PH(2) { phase2_elem(p); phase2_r1(p); }
#if PROBE_DOUBLE == 2
    phase2_r1(p);
#endif
#if PROBE_DOUBLE == 200
    for (int i_ = 0; i_ < 10; ++i_) GSYNC();
#endif
#if PROBE_DOUBLE == 12
    phase10_hn(p); phase10_hn(p);
#endif
    GSYNC(); STAMP();
    PH(3) phase3_scan(p);
    GSYNC(); STAMP();
    PH(4) { phase4_r3s(p, shm); phase4_r3(p); }
#if PROBE_DOUBLE == 4
    phase4_r3(p);
#endif
    GSYNC(); STAMP();
    PH(5) phase5_gemms(p, shm);
#if PROBE_DOUBLE == 5
    phase5_gemms(p, shm);
#endif
    GSYNC(); STAMP();
#if PROBE_DOUBLE == 6
    phase6_attn(p, shm, 1);
#endif
    PH(6) phase6_attn(p, shm);
    GSYNC(); STAMP();
    PH(7) { phase7_gates(p, shm); thin_phase<7>(p, shm); }
    STAMP();
    PH(8) { phase8_merge(p, shm); thin_phase<8>(p, shm); }
#if PROBE_DOUBLE == 8
    phase8_merge(p, shm);
#endif
    GSYNC(); STAMP();
    PH(9) { phase9_out(p, shm); thin_phase<9>(p, shm); }
    GSYNC(); STAMP();
    PH(11) phase11_gu(p, shm);
#if PROBE_DOUBLE == 11
    phase11_gu(p, shm);
#endif
    GSYNC(); STAMP();
    const bool fusedfin = gridDim.x == 256;
    PH(12) { phase12_down(p, shm, fusedfin); thin_phase<12>(p, shm); }
    GSYNC(); STAMP();
    PH(13) phase13_final(p, fusedfin ? TP : 0);
#ifdef TIMING_RUN
    STAMP();
    if (blockIdx.x == 0 && threadIdx.x == 0) {
        const unsigned long long d = tsb[TIMING_RUN + 1] - tsb[TIMING_RUN];
        const unsigned long long t0 = wall_clock64();
        while (wall_clock64() - t0 < d) __builtin_amdgcn_s_sleep(8);
    }
#endif
}

extern "C" void kernel_launch(void* const* d_in, const int* in_sizes, int n_in, void* d_out, int out_size, void* d_ws, size_t ws_size,
                              hipStream_t stream) {
    constexpr size_t kDynLds = 131072 + 16;
    static int grid_blocks = 0;
    if (!grid_blocks) {
        int dev = 0, cus = 0, per_cu = 0;
        hipGetDevice(&dev);
        hipDeviceGetAttribute(&cus, hipDeviceAttributeMultiprocessorCount, dev);
        hipFuncSetAttribute((const void*)fwd_megakernel, hipFuncAttributeMaxDynamicSharedMemorySize, (int)kDynLds);
        hipOccupancyMaxActiveBlocksPerMultiprocessor(&per_cu, fwd_megakernel, NTHREADS, kDynLds);
        if (per_cu < 1) per_cu = 1;
        grid_blocks = cus;
    }
    Params p{};
    const float** pp = (const float**)&p;
    for (int i = 0; i < 19; ++i) pp[i] = (const float*)d_in[i];
    p.out = (float*)d_out; p.ws = (char*)d_ws;
    hipMemsetAsync((char*)d_ws + OFF_CTR, 0, 65536 + 16896 * 4, stream);
    void* args[] = {&p};
    hipError_t e = hipLaunchCooperativeKernel((void*)fwd_megakernel, dim3(grid_blocks), dim3(NTHREADS), args, kDynLds, stream);
    if (e != hipSuccess) fprintf(stderr, "cooperative launch failed: %s (grid %d)\n", hipGetErrorString(e), grid_blocks);
}
```

```cpp
#include <hip/hip_runtime.h>
#include <hip/hip_cooperative_groups.h>
#include <cstdio>
#include <cstdint>
namespace cg = cooperative_groups;

typedef unsigned short bf16_t;
typedef short bf16x8 __attribute__((ext_vector_type(8)));
typedef float f32x4 __attribute__((ext_vector_type(4)));
typedef float f32x2 __attribute__((ext_vector_type(2)));
typedef float f32x16 __attribute__((ext_vector_type(16)));
typedef unsigned u32x4 __attribute__((ext_vector_type(4)));
typedef unsigned u32x2 __attribute__((ext_vector_type(2)));
typedef __bf16 bf16v2 __attribute__((ext_vector_type(2)));
#define DI __device__ __forceinline__

#ifndef PROBE_DOUBLE
#define PROBE_DOUBLE -1
#endif

constexpr int TP = 16384, TS = 512, TALL = 16896;
constexpr int NKV = 33280;
constexpr int NTHREADS = 512;

constexpr size_t SZ_WIN = 6144ull * 1024 * 2, SZ_WUQ = 1536ull * 512 * 2, SZ_WUKV = 2048ull * 256 * 2, SZ_W1K = 1024ull * 1024 * 2,
                 SZ_WGU = 5632ull * 1024 * 2, SZ_WDN = 1024ull * 2816 * 2;
constexpr size_t OFF_WIN = 0, OFF_WUQ = OFF_WIN + SZ_WIN, OFF_WUKV = OFF_WUQ + SZ_WUQ, OFF_WRO = OFF_WUKV + SZ_WUKV, OFF_WMO = OFF_WRO + SZ_W1K,
                 OFF_WOUT = OFF_WMO + SZ_W1K, OFF_WGU = OFF_WOUT + SZ_W1K, OFF_WDN = OFF_WGU + SZ_WGU;
constexpr size_t SZ_T1K = (size_t)TALL * 1024 * 2, SZ_T512 = (size_t)TALL * 512 * 2;
constexpr size_t OFF_XN = OFF_WDN + SZ_WDN;
constexpr size_t OFF_CKVALL = OFF_XN + SZ_T1K, SZ_CKVALL = (size_t)NKV * 256 * 2;
constexpr size_t OFF_KPEALL = OFF_CKVALL + SZ_CKVALL, SZ_KPEALL = (size_t)NKV * 64 * 2;
constexpr size_t OFF_POOL = OFF_KPEALL + SZ_KPEALL;
constexpr size_t OFF_CQ = OFF_POOL;
constexpr size_t OFF_RETIN = OFF_CQ + SZ_T512;
constexpr size_t OFF_CKVRAW = OFF_RETIN, OFF_KPERAW = OFF_CKVRAW + (size_t)TALL * 256 * 2;
constexpr size_t OFF_BIG = OFF_RETIN + SZ_T1K;
constexpr size_t OFF_RQ = OFF_BIG, OFF_RK = OFF_RQ + SZ_T512, OFF_RKT = OFF_RK + SZ_T512, OFF_RVT = OFF_RKT + SZ_T512, OFF_SRG = OFF_RVT + SZ_T1K;
constexpr size_t SZ_Q = (size_t)TALL * 1536 * 2, SZ_KNS = 8ull * 8 * 2112 * 128 * 2;
constexpr size_t OFF_Q = OFF_BIG, OFF_KNS = OFF_Q + SZ_Q, OFF_VTS = OFF_KNS + SZ_KNS;
constexpr size_t OFF_SGA = OFF_KNS, OFF_SGB = OFF_VTS;
constexpr size_t OFF_MERGED = OFF_XN, OFF_HN = OFF_CQ, OFF_ACT = OFF_BIG;
constexpr size_t OFF_CTR = OFF_BIG + 3 * SZ_T512 + 2 * SZ_T1K;
constexpr size_t OFF_BAR = OFF_CTR + 4096;
constexpr size_t OFF_ROWSS = OFF_CTR + 65536;
constexpr size_t OFF_PCNT = OFF_CTR + 32768;
constexpr size_t OFF_XBUF = OFF_CTR + 196608;
static_assert(OFF_XBUF + 64 * 4 * 256 * 4 <= 268435456ull, "xbuf");
static_assert(OFF_VTS + SZ_KNS == OFF_CTR, "mla overlay must match retention overlay");
static_assert(OFF_CTR + 65536 + 16896 * 4 <= 268435456ull, "workspace overflow");
constexpr size_t RKT_S = 2ull * 4 * 128 * 8192, RVT_S = 2ull * 4 * 256 * 8192;
constexpr size_t O_YP = 0, O_YS = 16777216, O_CKVP = 17301504, O_KPEP = 21495808, O_STP = 22544384, O_CKVS = 22806528, O_KPES = 22937600, O_STS = 22970368;
constexpr size_t SZ_KNP = 2ull * 8 * 8192 * 128 * 2;

__device__ const double THETA_REV[64] = {
0.15915494309189535, 0.13782250260398285, 0.11934937021124886, 0.10335229661843406, 0.08949940160889101, 0.07750328875537406, 0.06711508300522726, 0.058119267441876246, 0.050329212104487035, 0.04358330210530733, 0.03774158471741977, 0.032682865872357, 0.0283021958306234, 0.024508691862069852, 0.02122365276477766, 0.018378926105679667, 0.015915494309189534, 0.013782250260398284, 0.011934937021124886, 0.010335229661843406, 0.008949940160889102, 0.0077503288755374055, 0.006711508300522725, 0.005811926744187624, 0.005032921210448704, 0.004358330210530733, 0.003774158471741977, 0.0032682865872356993, 0.00283021958306234, 0.002450869186206985, 0.0021223652764777662, 0.0018378926105679667, 0.0015915494309189536, 0.0013782250260398288, 0.0011934937021124885, 0.0010335229661843405, 0.0008949940160889102, 0.0007750328875537405, 0.0006711508300522726, 0.0005811926744187624, 0.0005032921210448703, 0.0004358330210530733, 0.00037741584717419774, 0.0003268286587235699, 0.00028302195830623395, 0.00024508691862069854, 0.0002122365276477766, 0.00018378926105679666, 0.00015915494309189535, 0.00013782250260398286, 0.00011934937021124886, 0.00010335229661843406, 8.949940160889102e-05, 7.750328875537406e-05, 6.711508300522725e-05, 5.811926744187624e-05, 5.0329212104487035e-05, 4.358330210530732e-05, 3.774158471741978e-05, 3.2682865872357e-05, 2.8302195830623396e-05, 2.4508691862069852e-05, 2.122365276477766e-05, 1.8378926105679668e-05};

struct Params {
    const float *x_p, *x_s, *c_ckv, *c_kpe, *st, *nmix, *w_in, *qn, *w_uq, *kvn, *w_ukv, *gn, *w_ro, *w_mo, *w_out, *nffn, *w_gu, *w_dn, *nfin;
    float* out;
    char* ws;
};

DI float bf2f(bf16_t h) { return __uint_as_float((unsigned)h << 16); }
DI unsigned pk2(float lo, float hi) {
    f32x2 v = {lo, hi};
    bf16v2 b = __builtin_convertvector(v, bf16v2);
    return __builtin_bit_cast(unsigned, b);
}
DI bf16_t f2bf(float x) { return (bf16_t)(pk2(x, 0.f) & 0xffffu); }
DI u32x2 pk4(f32x4 v) { u32x2 r; r.x = pk2(v[0], v[1]); r.y = pk2(v[2], v[3]); return r; }
DI float fexp2(float x) { return __builtin_amdgcn_exp2f(x); }
DI float frcp(float x) { return __builtin_amdgcn_rcpf(x); }
DI float sigmoidf_(float x) { return frcp(1.0f + fexp2(-1.44269504089f * x)); }
DI float siluf_(float x) { return x * sigmoidf_(x); }
typedef unsigned u32v2_t __attribute__((ext_vector_type(2)));
DI float xhalf_max(float v) { const u32v2_t r = __builtin_amdgcn_permlane32_swap(__float_as_uint(v), __float_as_uint(v), false, false); return fmaxf(__uint_as_float(r.x), __uint_as_float(r.y)); }
DI float xhalf_sum(float v) { const u32v2_t r = __builtin_amdgcn_permlane32_swap(__float_as_uint(v), __float_as_uint(v), false, false); return __uint_as_float(r.x) + __uint_as_float(r.y); }
DI float wave_sum(float v) {
#pragma unroll
    for (int o = 32; o >= 1; o >>= 1) v += __shfl_xor(v, o);
    return v;
}
DI void rope_cs(int pos, int i, float& c, float& s) {
    double r = (double)pos * THETA_REV[i];
    r = r - __builtin_floor(r);
    const float rf = (float)r;
    s = __builtin_amdgcn_sinf(rf);
    c = __builtin_amdgcn_cosf(rf);
}
DI float lg2gamma(int h) { return h == 0 ? -0.04580368961312479f : h == 1 ? -0.02272007650008353f : h == 2 ? -0.011315313227834146f : -0.005646563141142063f; }
struct RowInfo { int isS, b, t, pos; };
DI RowInfo rinfo(int row) {
    RowInfo r;
    if (row < TP) { r.isS = 0; r.b = row >> 13; r.t = row & 8191; r.pos = r.t; }
    else { const int q = row - TP; r.isS = 1; r.b = q >> 6; r.t = q & 63; r.pos = 2048 + r.t; }
    return r;
}
DI int kvrow(const RowInfo& ri, int row) { return ri.isS ? (TP + ri.b * 2112 + 2048 + ri.t) : row; }

constexpr int BM = 256, BK = 64, HALF = 128, HT = HALF * BK;
DI int lds_byte(int r, int c) {
    int st = (r >> 4) * 2 + (c >> 5), rr = r & 15, cc = c & 31, ob = rr * 64 + cc * 2;
    return st * 1024 + (ob ^ (((ob >> 9) & 1) << 5));
}
DI void stage_rc(int b, int& R, int& C) {
    int st = b / 1024, sb = b % 1024, swz = sb ^ (((sb >> 9) & 1) << 5);
    R = (st >> 1) * 16 + swz / 64; C = (st & 1) * 32 + (swz % 64) / 2;
}
DI bool tile_order(int L, int nM, int nN, int& pm, int& pn) {
    const int nwg = nM * nN;
    if (L >= nwg) return false;
    int wgid = L;
    { const int q = nwg / 8, r = nwg % 8, xcd = wgid % 8, off = wgid / 8; wgid = (xcd < r ? xcd * (q + 1) : r * (q + 1) + (xcd - r) * q) + off; }
    const int nig = 8 * nN, gid = wgid / nig, fm = gid * 8, gsz = (nM - fm) < 8 ? (nM - fm) : 8;
    pm = fm + ((wgid % nig) % gsz); pn = (wgid % nig) / gsz;
    return true;
}

#define LAS __attribute__((address_space(3)))
DI void gemm_kloop(f32x4 (&acc)[2][2][4][2], const bf16_t* __restrict__ A, int lda, bool a192, const bf16_t* __restrict__ Bt, int ldb, int nt,
                   int brow, int bcol, LAS unsigned char* lds) {
    int tid = threadIdx.x; asm volatile("" : "+v"(tid));
    const int wid = __builtin_amdgcn_readfirstlane(tid >> 6), lane = tid & 63, wr = wid >> 2, wc = wid & 3, fr = lane & 15, fq = lane >> 4;
    unsigned voffA[2], voffB[2];
#pragma unroll
    for (int i = 0; i < 2; ++i) { int R, C; stage_rc(tid * 16 + i * 8192, R, C); voffA[i] = (unsigned)(R * lda + C) * 2u; voffB[i] = (unsigned)(R * ldb + C) * 2u; }
    const size_t hstepA = (size_t)HALF * lda * 2, hstepB = (size_t)HALF * ldb * 2;
    const unsigned ldsw = (unsigned)wid * 1024u;
    const int aoff = lds_byte(wr * 64 + fr, fq * 8), boff = lds_byte(wc * 32 + fr, fq * 8);
    const char* cA = (const char*)A + (size_t)brow * lda * 2;
    const char* cB = (const char*)Bt + (size_t)bcol * ldb * 2;
    constexpr int HTB = HALF * BK * 2;
#define SA(b, h) (((b) * 2 + (h)) * HTB)
#define SB(b, h) ((4 + (b) * 2 + (h)) * HTB)
#define AKO(kt) ((size_t)(a192 ? (((kt) >> 1) * 192 + ((kt) & 1) * 64) : (kt) * 64) * 2)
#define STAGE_(bufoff, gbase, voff) do { _Pragma("unroll") for (int _i = 0; _i < 2; ++_i) \
      __builtin_amdgcn_global_load_lds((const unsigned*)((const char*)(gbase) + (voff)[_i]), (LAS unsigned*)(lds + (bufoff) + ldsw + _i * 8192), 16, 0, 0); } while (0)
#define STAGEA(buf, h, kt) STAGE_(buf, cA + (h) * hstepA + AKO(kt), voffA)
#define STAGEB(buf, h, kt) STAGE_(buf, cB + (h) * hstepB + (size_t)(kt) * 128, voffB)
#define LDA(dst, b, h) do { _Pragma("unroll") for (int m = 0; m < 4; ++m) _Pragma("unroll") for (int k = 0; k < 2; ++k) dst[m][k] = *(const LAS bf16x8*)(lds + SA(b, h) + aoff + m * 2048 + k * 1024); } while (0)
#define LDB(dst, b, h) do { _Pragma("unroll") for (int n = 0; n < 2; ++n) _Pragma("unroll") for (int k = 0; k < 2; ++k) dst[n][k] = *(const LAS bf16x8*)(lds + SB(b, h) + boff + n * 2048 + k * 1024); } while (0)
#define MMA(ai, bj, At_, Bt_) do { __builtin_amdgcn_s_setprio(1); _Pragma("unroll") for (int m = 0; m < 4; ++m) _Pragma("unroll") for (int n = 0; n < 2; ++n) _Pragma("unroll") for (int k = 0; k < 2; ++k) \
      acc[ai][bj][m][n] = __builtin_amdgcn_mfma_f32_16x16x32_bf16(Bt_[n][k], At_[m][k], acc[ai][bj][m][n], 0, 0, 0); \
    __builtin_amdgcn_s_setprio(0); } while (0)
#define WAIT_V(n) asm volatile("s_waitcnt vmcnt(" #n ")" ::: "memory")
#define WAIT_L(n) asm volatile("s_waitcnt lgkmcnt(" #n ")" ::: "memory")
#define BAR __builtin_amdgcn_s_barrier()
#define SCHED __builtin_amdgcn_sched_barrier(0)
    bf16x8 At[4][2], B0[2][2], B1[2][2];
    WAIT_V(0);
    STAGEB(SB(0, 0), 0, 0); STAGEA(SA(0, 0), 0, 0);
    STAGEB(SB(0, 1), 1, 0); STAGEA(SA(0, 1), 1, 0);
    if (wr == 1) BAR;
    WAIT_V(4); BAR;
    STAGEB(SB(1, 0), 0, 1); STAGEA(SA(1, 0), 0, 1); STAGEB(SB(1, 1), 1, 1);
    WAIT_V(6); BAR;
    for (int t = 0; t < nt - 2; t += 2) {
        LDB(B0, 0, 0); SCHED; LDA(At, 0, 0); STAGEA(SA(1, 1), 1, t + 1);
        WAIT_L(8); BAR; WAIT_L(0); MMA(0, 0, At, B0); BAR; SCHED;
        LDB(B1, 0, 1); STAGEB(SB(0, 0), 0, t + 2);
        BAR; WAIT_L(0); MMA(0, 1, At, B1); BAR;
        LDA(At, 0, 1); STAGEA(SA(0, 0), 0, t + 2);
        BAR; WAIT_L(0); MMA(1, 0, At, B0); BAR; SCHED;
        STAGEB(SB(0, 1), 1, t + 2);
        WAIT_V(6); BAR; MMA(1, 1, At, B1); BAR;
        LDB(B0, 1, 0); SCHED; LDA(At, 1, 0); STAGEA(SA(0, 1), 1, t + 2);
        WAIT_L(8); BAR; WAIT_L(0); MMA(0, 0, At, B0); BAR; SCHED;
        LDB(B1, 1, 1); STAGEB(SB(1, 0), 0, t + 3);
        BAR; WAIT_L(0); MMA(0, 1, At, B1); BAR;
        LDA(At, 1, 1); STAGEA(SA(1, 0), 0, t + 3);
        BAR; WAIT_L(0); MMA(1, 0, At, B0); BAR; SCHED;
        STAGEB(SB(1, 1), 1, t + 3);
        WAIT_V(6); BAR; MMA(1, 1, At, B1); BAR;
    }
    { LDB(B0, 0, 0); LDA(At, 0, 0); STAGEA(SA(1, 1), 1, nt - 1);
      BAR; WAIT_L(0); MMA(0, 0, At, B0); BAR;
      LDB(B1, 0, 1); BAR; WAIT_L(0); MMA(0, 1, At, B1); BAR;
      LDA(At, 0, 1); WAIT_V(4); BAR; WAIT_L(0); MMA(1, 0, At, B0); MMA(1, 1, At, B1); BAR; }
    { LDB(B0, 1, 0); LDA(At, 1, 0); WAIT_V(2); BAR; WAIT_L(0); MMA(0, 0, At, B0); BAR;
      LDB(B1, 1, 1); WAIT_V(0); BAR; WAIT_L(0); MMA(0, 1, At, B1); BAR;
      LDA(At, 1, 1); BAR; WAIT_L(0); MMA(1, 0, At, B0); MMA(1, 1, At, B1); BAR; }
    if (wr == 0) BAR;
}
#define ZERO_ACC(acc) for (int a_ = 0; a_ < 2; ++a_) for (int b_ = 0; b_ < 2; ++b_) for (int m_ = 0; m_ < 4; ++m_) for (int n_ = 0; n_ < 2; ++n_) acc[a_][b_][m_][n_] = (f32x4){0.f, 0.f, 0.f, 0.f}
struct GUnit { const bf16_t* a; const bf16_t* b; int pm, pn; };
template <bool AFTER_DRAIN = false, class Sched, class Epi>
DI void gemm_stream(LAS unsigned char* lds, int lda, bool a192, int ldb, int nt, const Sched& S, const Epi& E) {
    int tid = threadIdx.x; asm volatile("" : "+v"(tid));
    const int wid = __builtin_amdgcn_readfirstlane(tid >> 6), lane = tid & 63, wr = wid >> 2, wc = wid & 3, fr = lane & 15, fq = lane >> 4;
    GUnit cur, nxt; int ui = 0;
    if (!S.next(0, cur)) return;
    unsigned voffA[2], voffB[2];
#pragma unroll
    for (int i = 0; i < 2; ++i) { int R, C; stage_rc(tid * 16 + i * 8192, R, C); voffA[i] = (unsigned)(R * lda + C) * 2u; voffB[i] = (unsigned)(R * ldb + C) * 2u; }
    const size_t hstepA = (size_t)HALF * lda * 2, hstepB = (size_t)HALF * ldb * 2;
    const unsigned ldsw = (unsigned)wid * 1024u;
    const int aoff = lds_byte(wr * 64 + fr, fq * 8), boff = lds_byte(wc * 32 + fr, fq * 8);
    constexpr int HTB = HALF * BK * 2;
#define GS_STAGE(bufoff, gbase, voff) do { _Pragma("unroll") for (int _i = 0; _i < 2; ++_i) \
      __builtin_amdgcn_global_load_lds((const unsigned*)((const char*)(gbase) + (voff)[_i]), (LAS unsigned*)(lds + (bufoff) + ldsw + _i * 8192), 16, 0, 0); } while (0)
    f32x4 acc[2][2][4][2];
    ZERO_ACC(acc);
    bf16x8 At[4][2], B0[2][2], B1[2][2];
    const char* cA = (const char*)cur.a; const char* cB = (const char*)cur.b;
    WAIT_V(0);
    GS_STAGE(SB(0, 0), cB, voffB); GS_STAGE(SB(0, 1), cB + hstepB, voffB); GS_STAGE(SA(0, 0), cA, voffA); GS_STAGE(SA(0, 1), cA + hstepA, voffA);
    if (wr == 1) BAR;
    WAIT_V(2); BAR;
    GS_STAGE(SB(1, 0), cB + 128, voffB); GS_STAGE(SA(1, 0), cA + 128, voffA); GS_STAGE(SB(1, 1), cB + hstepB + 128, voffB);
    WAIT_V(6); BAR;
    for (;;) {
        const bool has_next = S.next(ui + 1, nxt);
        const char* nA = has_next ? (const char*)nxt.a : cA; const char* nB = has_next ? (const char*)nxt.b : cB;
        for (int t = 0; t < nt; t += 2) {
            const bool last = (t == nt - 2);
            const char* a1 = cA + AKO(t + 1);
            const char* a2 = last ? nA : cA + AKO(t + 2); const char* b2 = last ? nB : cB + (size_t)(t + 2) * 128;
            const char* a3 = a2 + 128; const char* b3 = b2 + 128;
            LDB(B0, 0, 0); LDB(B1, 0, 1); SCHED; LDA(At, 0, 0); GS_STAGE(SA(1, 1), a1 + hstepA, voffA);
            WAIT_V(8); WAIT_L(0); BAR; MMA(0, 0, At, B0); MMA(0, 1, At, B1); BAR; SCHED;
            LDA(At, 0, 1); GS_STAGE(SB(0, 0), b2, voffB); GS_STAGE(SB(0, 1), b2 + hstepB, voffB); GS_STAGE(SA(0, 0), a2, voffA);
            WAIT_V(8); WAIT_L(0); BAR; MMA(1, 0, At, B0); MMA(1, 1, At, B1); BAR; SCHED;
            LDB(B0, 1, 0); LDB(B1, 1, 1); SCHED; LDA(At, 1, 0); GS_STAGE(SA(0, 1), a2 + hstepA, voffA);
            WAIT_V(8); WAIT_L(0); BAR; MMA(0, 0, At, B0); MMA(0, 1, At, B1); BAR; SCHED;
            LDA(At, 1, 1); GS_STAGE(SB(1, 0), b3, voffB); GS_STAGE(SB(1, 1), b3 + hstepB, voffB); GS_STAGE(SA(1, 0), a3, voffA);
            WAIT_V(8); WAIT_L(0); BAR; MMA(1, 0, At, B0); MMA(1, 1, At, B1); BAR; SCHED;
        }
        if (!AFTER_DRAIN || has_next) E(acc, cur);
        if (!has_next) break;
        ZERO_ACC(acc);
        cur = nxt; cA = nA; cB = nB; ++ui;
    }
    WAIT_V(0);
    if (wr == 0) BAR;
    BAR;
    if (AFTER_DRAIN) E(acc, cur);
#undef GS_STAGE
}
#define EPI_IDS int lane = threadIdx.x & 63, wid = __builtin_amdgcn_readfirstlane(threadIdx.x >> 6); asm volatile("" : "+v"(lane), "+s"(wid)); const int wr = wid >> 2, wc = wid & 3, fr = lane & 15, fq = lane >> 4

template <class F>
DI void conv_w(const float* __restrict__ W, int K, int Norig, bf16_t* __restrict__ Wt, int Nt, F perm, LAS unsigned char* lds) {
    int tid = threadIdx.x; asm volatile("" : "+v"(tid));
    const int lane = tid & 63, w = tid >> 6, nl = tid >> 3, ch = tid & 7;
    const int ntn = Nt / 64, total = (K / 64) * ntn;
    float v[8], vn[8];
    int t = blockIdx.x;
    if (t < total) {
        const int tn = t % ntn, tk = t / ntn, col = perm(tn * 64 + lane);
#pragma unroll
        for (int j = 0; j < 8; ++j) v[j] = col >= 0 ? W[(size_t)(tk * 64 + w * 8 + j) * Norig + col] : 0.f;
    }
    for (; t < total; t += gridDim.x) {
        const int t2 = t + gridDim.x;
        if (t2 < total) {
            const int tn = t2 % ntn, tk = t2 / ntn, col = perm(tn * 64 + lane);
#pragma unroll
            for (int j = 0; j < 8; ++j) vn[j] = col >= 0 ? W[(size_t)(tk * 64 + w * 8 + j) * Norig + col] : 0.f;
        }
        const int tn = t % ntn, tk = t / ntn;
        __syncthreads();
        u32x4 o; o.x = pk2(v[0], v[1]); o.y = pk2(v[2], v[3]); o.z = pk2(v[4], v[5]); o.w = pk2(v[6], v[7]);
        *(LAS u32x4*)(lds + lane * 144 + w * 16) = o;
        __syncthreads();
        *(u32x4*)(Wt + (size_t)(tn * 64 + nl) * K + tk * 64 + ch * 8) = *(const LAS u32x4*)(lds + nl * 144 + ch * 16);
#pragma unroll
        for (int j = 0; j < 8; ++j) v[j] = vn[j];
    }
    __syncthreads();
}
DI int perm_win(int n) {
    const int tc = n >> 8, c = n & 255;
    if (tc < 4) { const int half = c >> 7, e = (c >> 6) & 1, i = c & 63; return (tc >> 1) * 512 + (2 * (tc & 1) + e) * 128 + half * 64 + i; }
    if (tc < 15) return n;
    if (tc == 15) return c < 64 ? 3840 + c : -1;
    return 3904 + (n - 4096);
}
DI int perm_wuq(int n) {
    const int tc = n >> 8, c = n & 255;
    if (tc < 4) { const int e = c >> 7, d = c & 127; return (2 * tc + e) * 192 + d; }
    const int half = c >> 7, e = (c >> 5) & 3, i = c & 31;
    return (4 * (tc - 4) + e) * 192 + 128 + half * 32 + i;
}
DI int perm_wukv(int n) {
    const int tc = n >> 8, c = n & 255;
    const int e = c >> 7, d = c & 127;
    if (tc < 4) return (2 * tc + e) * 256 + d;
    return (2 * (tc - 4) + e) * 256 + 128 + d;
}
DI int perm_wgu(int n) { const int tc = n >> 8, c = n & 255; return (c >> 7) * 2816 + tc * 128 + (c & 127); }
DI int perm_id(int n) { return n; }

DI void rmsnorm_row_1024(const float* __restrict__ x, const float* __restrict__ g, bf16_t* __restrict__ o, int lane) {
    f32x4 v[4]; float ss = 0.f;
#pragma unroll
    for (int i = 0; i < 4; ++i) { v[i] = *(const f32x4*)(x + i * 256 + lane * 4); ss += v[i][0] * v[i][0] + v[i][1] * v[i][1] + v[i][2] * v[i][2] + v[i][3] * v[i][3]; }
    ss = wave_sum(ss);
    const float rstd = rsqrtf(ss * (1.0f / 1024.0f) + 1e-6f);
#pragma unroll
    for (int i = 0; i < 4; ++i) { const f32x4 gg = *(const f32x4*)(g + i * 256 + lane * 4); *(u32x2*)(o + i * 256 + lane * 4) = pk4(v[i] * rstd * gg); }
}

DI void rmsnorm_row2_1024(const float* __restrict__ xa, const float* __restrict__ xb, const float* __restrict__ g, bf16_t* __restrict__ oa, bf16_t* __restrict__ ob, int lane) {
    f32x4 va[4], vb[4]; float sa = 0.f, sb = 0.f;
#pragma unroll
    for (int i = 0; i < 4; ++i) { va[i] = *(const f32x4*)(xa + i * 256 + lane * 4); vb[i] = *(const f32x4*)(xb + i * 256 + lane * 4); }
#pragma unroll
    for (int i = 0; i < 4; ++i) { sa += va[i][0] * va[i][0] + va[i][1] * va[i][1] + va[i][2] * va[i][2] + va[i][3] * va[i][3]; sb += vb[i][0] * vb[i][0] + vb[i][1] * vb[i][1] + vb[i][2] * vb[i][2] + vb[i][3] * vb[i][3]; }
    sa = wave_sum(sa); sb = wave_sum(sb);
    const float ra = rsqrtf(sa * (1.0f / 1024.0f) + 1e-6f), rb = rsqrtf(sb * (1.0f / 1024.0f) + 1e-6f);
#pragma unroll
    for (int i = 0; i < 4; ++i) { const f32x4 gg = *(const f32x4*)(g + i * 256 + lane * 4); *(u32x2*)(oa + i * 256 + lane * 4) = pk4(va[i] * ra * gg); *(u32x2*)(ob + i * 256 + lane * 4) = pk4(vb[i] * rb * gg); }
}

DI void phase0(const Params& p, LAS unsigned char* lds) {
    const int gtid = blockIdx.x * NTHREADS + threadIdx.x, nth = gridDim.x * NTHREADS;
    char* ws = p.ws;
    if (gtid < 64) ((unsigned*)(ws + OFF_CTR))[gtid] = (gtid == 33) ? 1u : 0u;
    conv_w(p.w_in, 1024, 5952, (bf16_t*)(ws + OFF_WIN), 6144, perm_win, lds);
    conv_w(p.w_uq, 512, 1536, (bf16_t*)(ws + OFF_WUQ), 1536, perm_wuq, lds);
    conv_w(p.w_ukv, 256, 2048, (bf16_t*)(ws + OFF_WUKV), 2048, perm_wukv, lds);
    conv_w(p.w_ro, 1024, 1024, (bf16_t*)(ws + OFF_WRO), 1024, perm_id, lds);
    conv_w(p.w_mo, 1024, 1024, (bf16_t*)(ws + OFF_WMO), 1024, perm_id, lds);
    conv_w(p.w_out, 1024, 1024, (bf16_t*)(ws + OFF_WOUT), 1024, perm_id, lds);
    conv_w(p.w_gu, 1024, 5632, (bf16_t*)(ws + OFF_WGU), 5632, perm_wgu, lds);
    conv_w(p.w_dn, 2816, 1024, (bf16_t*)(ws + OFF_WDN), 1024, perm_id, lds);
    const int gw = gtid >> 6, nw = nth >> 6, lane = threadIdx.x & 63;
    bf16_t* xn = (bf16_t*)(ws + OFF_XN);
    for (int row = gw; row < TALL; row += 2 * nw) {
        const int row2 = row + nw;
        const float* x = row < TP ? p.x_p + (size_t)row * 1024 : p.x_s + (size_t)(row - TP) * 1024;
        if (row2 < TALL) {
            const float* x2 = row2 < TP ? p.x_p + (size_t)row2 * 1024 : p.x_s + (size_t)(row2 - TP) * 1024;
            rmsnorm_row2_1024(x, x2, p.nmix, xn + (size_t)row * 1024, xn + (size_t)row2 * 1024, lane);
        } else rmsnorm_row_1024(x, p.nmix, xn + (size_t)row * 1024, lane);
    }
    bf16_t* ckvall = (bf16_t*)(ws + OFF_CKVALL); bf16_t* kpeall = (bf16_t*)(ws + OFF_KPEALL);
    for (int idx = gtid; idx < 8 * 2048 * 64; idx += nth) {
        const int c4 = idx & 63, r = idx >> 6, b = r >> 11, j = r & 2047;
        const f32x4 v = *(const f32x4*)(p.c_ckv + (size_t)r * 256 + c4 * 4);
        *(u32x2*)(ckvall + (size_t)(TP + b * 2112 + j) * 256 + c4 * 4) = pk4(v);
    }
    for (int idx = gtid; idx < 8 * 2048 * 16; idx += nth) {
        const int c4 = idx & 15, r = idx >> 4, b = r >> 11, j = r & 2047;
        const f32x4 v = *(const f32x4*)(p.c_kpe + (size_t)r * 64 + c4 * 4);
        *(u32x2*)(kpeall + (size_t)(TP + b * 2112 + j) * 64 + c4 * 4) = pk4(v);
    }
}

DI void epi_win(const Params& p, const f32x4 (&acc)[2][2][4][2], int pm, int tc) {
    EPI_IDS;
    char* ws = p.ws;
    const int row0 = pm * 256 + wr * 64 + fr;
    if (tc < 4) {
        const bool isK = tc >= 2;
        bf16_t* nat = (bf16_t*)(ws + (isK ? OFF_RK : OFF_RQ));
        const float sc = isK ? 0.08838834764831845f : 1.0f;
#pragma unroll
        for (int ai = 0; ai < 2; ++ai)
#pragma unroll
            for (int m = 0; m < 4; ++m) {
                const int row = row0 + ai * 128 + m * 16;
                const RowInfo ri = rinfo(row);
#pragma unroll
                for (int n = 0; n < 2; ++n) {
                    const int cw = wc * 32 + n * 16 + fq * 4, e = cw >> 6, i0 = cw & 63, head = 2 * (tc & 1) + e;
                    const f32x4 x1 = acc[ai][0][m][n], x2 = acc[ai][1][m][n];
                    f32x4 o1, o2;
#pragma unroll
                    for (int j = 0; j < 4; ++j) { float c, s; rope_cs(ri.pos, i0 + j, c, s); o1[j] = (x1[j] * c - x2[j] * s) * sc; o2[j] = (x1[j] * s + x2[j] * c) * sc; }
                    *(u32x2*)(nat + (size_t)row * 512 + head * 128 + i0) = pk4(o1);
                    *(u32x2*)(nat + (size_t)row * 512 + head * 128 + 64 + i0) = pk4(o2);
                }
            }
    } else {
        bf16_t* dst; int ld, cbase, act = 0;
        if (tc < 12) { dst = (bf16_t*)(ws + OFF_SRG); ld = 1024; cbase = (tc - 8) * 256; act = 1; }
        else if (tc < 14) { dst = (bf16_t*)(ws + OFF_CQ); ld = 512; cbase = (tc - 12) * 256; }
        else if (tc == 14) { dst = (bf16_t*)(ws + OFF_CKVRAW); ld = 256; cbase = 0; }
        else if (tc == 15) { dst = (bf16_t*)(ws + OFF_KPERAW); ld = 64; cbase = 0; }
        else if (tc < 20) { dst = (bf16_t*)(ws + OFF_SGA); ld = 1024; cbase = (tc - 16) * 256; act = 2; }
        else { dst = (bf16_t*)(ws + OFF_SGB); ld = 1024; cbase = (tc - 20) * 256; act = 2; }
#pragma unroll
        for (int ai = 0; ai < 2; ++ai)
#pragma unroll
            for (int m = 0; m < 4; ++m) {
                const int row = row0 + ai * 128 + m * 16;
#pragma unroll
                for (int bj = 0; bj < 2; ++bj)
#pragma unroll
                    for (int n = 0; n < 2; ++n) {
                        const int c = bj * 128 + wc * 32 + n * 16 + fq * 4;
                        if (tc == 15 && c >= 64) continue;
                        f32x4 v = acc[ai][bj][m][n];
                        if (act == 1) { for (int j = 0; j < 4; ++j) v[j] = siluf_(v[j]); }
                        else if (act == 2) { for (int j = 0; j < 4; ++j) v[j] = sigmoidf_(v[j]); }
                        *(u32x2*)(dst + (size_t)row * ld + cbase + c) = pk4(v);
                    }
            }
    }
}
DI void epi_win_T(const Params& p, const f32x4 (&acc)[2][2][4][2], int pm, int tc) {
    EPI_IDS;
    char* ws = p.ws;
    if (tc < 4) {
        bf16_t* rkt = (bf16_t*)(ws + OFF_RKT);
        const int head = 2 * (tc & 1) + wr;
        const float lg = lg2gamma(head), sc = 0.08838834764831845f;
#pragma unroll
        for (int bj = 0; bj < 2; ++bj)
#pragma unroll
            for (int n = 0; n < 2; ++n) {
                const int tok0 = pm * 256 + bj * 128 + wc * 32 + n * 16 + fq * 4;
                const RowInfo ri = rinfo(tok0);
                bf16_t* dst = ri.isS ? rkt + RKT_S + (size_t)(ri.b * 4 + head) * 8192 + ri.t
                                     : rkt + ((size_t)(ri.b * 4 + head) * 128 + (ri.t >> 6)) * 8192 + (ri.t & 63);
                f32x4 dec;
#pragma unroll
                for (int j = 0; j < 4; ++j) dec[j] = sc * fexp2((float)(63 - ((ri.t + j) & 63)) * lg);
#pragma unroll
                for (int m = 0; m < 4; ++m) {
                    const int i = m * 16 + fr;
                    const f32x4 x1 = acc[0][bj][m][n], x2 = acc[1][bj][m][n];
                    f32x4 o1, o2;
#pragma unroll
                    for (int j = 0; j < 4; ++j) { float c, s; rope_cs(ri.pos + j, i, c, s); o1[j] = (x1[j] * c - x2[j] * s) * dec[j]; o2[j] = (x1[j] * s + x2[j] * c) * dec[j]; }
                    *(u32x2*)(dst + i * 64) = pk4(o1);
                    *(u32x2*)(dst + (64 + i) * 64) = pk4(o2);
                }
            }
    } else {
        bf16_t* rvt = (bf16_t*)(ws + OFF_RVT);
        const int head = tc - 4;
#pragma unroll
        for (int bj = 0; bj < 2; ++bj)
#pragma unroll
            for (int n = 0; n < 2; ++n) {
                const int tok0 = pm * 256 + bj * 128 + wc * 32 + n * 16 + fq * 4;
                const RowInfo ri = rinfo(tok0);
                bf16_t* dst = ri.isS ? rvt + RVT_S + (size_t)(ri.b * 4 + head) * 16384 + ri.t
                                     : rvt + ((size_t)(ri.b * 4 + head) * 128 + (ri.t >> 6)) * 16384 + (ri.t & 63);
#pragma unroll
                for (int ai = 0; ai < 2; ++ai)
#pragma unroll
                    for (int m = 0; m < 4; ++m) *(u32x2*)(dst + (ai * 128 + wr * 64 + m * 16 + fr) * 64) = pk4(acc[ai][bj][m][n]);
            }
    }
}
DI void phase_gemm_in(const Params& p, int tc0, int ntc, LAS unsigned char* shm, int nM = TALL / 256) {
    const bf16_t* A = (const bf16_t*)(p.ws + OFF_XN);
    const bf16_t* Bt = (const bf16_t*)(p.ws + OFF_WIN);
    for (int L = blockIdx.x;; L += gridDim.x) {
        int pm, pn; if (!tile_order(L, nM, ntc, pm, pn)) break;
        f32x4 acc[2][2][4][2]; ZERO_ACC(acc);
        gemm_kloop(acc, A, 1024, false, Bt, 1024, 16, pm * 256, (tc0 + pn) * 256, shm);
        epi_win(p, acc, pm, tc0 + pn);
    }
}

DI void phase7_gates(const Params& p, LAS unsigned char* shm) {
    const bf16_t* A = (const bf16_t*)(p.ws + OFF_XN);
    const bf16_t* Bt = (const bf16_t*)(p.ws + OFF_WIN);
#pragma unroll 1
    for (int g = 0; g < 2; ++g)
        for (int L = blockIdx.x;; L += gridDim.x) {
            int pm, pn; if (!tile_order(L, 64, 4, pm, pn)) break;
            const int tc = 16 + 4 * g + pn;
            f32x4 acc[2][2][4][2]; ZERO_ACC(acc);
            gemm_kloop(acc, A, 1024, false, Bt, 1024, 16, pm * 256, tc * 256, shm);
            epi_win(p, acc, pm, tc);
        }
}
struct SchedP1 {
    const bf16_t* X; const bf16_t* W;
    DI bool next(int i, GUnit& u) const {
        int pm, pn; if (!tile_order(blockIdx.x + i * gridDim.x, TALL / 256, 18, pm, pn)) return false;
        u.pm = pm; u.pn = pn;
        if (pn < 12) { const int tc = pn < 4 ? pn : pn + 4; u.a = X + (size_t)pm * 256 * 1024; u.b = W + (size_t)tc * 256 * 1024; }
        else { const int tc = pn - 10; u.a = W + (size_t)tc * 256 * 1024; u.b = X + (size_t)pm * 256 * 1024; }
        return true;
    }
};
struct EpiP1 {
    Params p;
    DI void operator()(const f32x4 (&acc)[2][2][4][2], const GUnit& u) const {
        if (u.pn < 12) epi_win(p, acc, u.pm, u.pn < 4 ? u.pn : u.pn + 4); else epi_win_T(p, acc, u.pm, u.pn - 10);
    }
};
DI void phase1_gemm(const Params& p, LAS unsigned char* shm) {
    const SchedP1 S{(const bf16_t*)(p.ws + OFF_XN), (const bf16_t*)(p.ws + OFF_WIN)};
    const EpiP1 E{p};
    gemm_stream(shm, 1024, false, 1024, 16, S, E);
}

DI void phase2_elem(const Params& p) {
    const int skip = gridDim.x > 64 ? 32 : 0;
    if ((int)blockIdx.x < skip) return;
    const int gw = ((int)blockIdx.x - skip) * 8 + (threadIdx.x >> 6), nw = ((int)gridDim.x - skip) * 8, lane = threadIdx.x & 63;
    char* ws = p.ws;
    bf16_t* cq = (bf16_t*)(ws + OFF_CQ);
    const bf16_t* ckvraw = (const bf16_t*)(ws + OFF_CKVRAW);
    const bf16_t* kperaw = (const bf16_t*)(ws + OFF_KPERAW);
    bf16_t* ckvall = (bf16_t*)(ws + OFF_CKVALL); bf16_t* kpeall = (bf16_t*)(ws + OFF_KPEALL);
    for (int row = gw; row < TALL; row += nw) {
        const RowInfo ri = rinfo(row);
        const int kr = kvrow(ri, row);
        {
            const u32x4 raw = *(const u32x4*)(cq + (size_t)row * 512 + lane * 8);
            float v[8];
#pragma unroll
            for (int j = 0; j < 4; ++j) { v[2 * j] = __uint_as_float(raw[j] << 16); v[2 * j + 1] = __uint_as_float(raw[j] & 0xffff0000u); }
            float ss = 0.f;
#pragma unroll
            for (int j = 0; j < 8; ++j) ss += v[j] * v[j];
            ss = wave_sum(ss);
            const float rstd = rsqrtf(ss * (1.0f / 512.0f) + 1e-6f);
            const f32x4 g0 = *(const f32x4*)(p.qn + lane * 8), g1 = *(const f32x4*)(p.qn + lane * 8 + 4);
            u32x4 o; o.x = pk2(v[0] * rstd * g0[0], v[1] * rstd * g0[1]); o.y = pk2(v[2] * rstd * g0[2], v[3] * rstd * g0[3]);
            o.z = pk2(v[4] * rstd * g1[0], v[5] * rstd * g1[1]); o.w = pk2(v[6] * rstd * g1[2], v[7] * rstd * g1[3]);
            *(u32x4*)(cq + (size_t)row * 512 + lane * 8) = o;
        }
        {
            const u32x2 raw = *(const u32x2*)(ckvraw + (size_t)row * 256 + lane * 4);
            f32x4 v; v[0] = __uint_as_float(raw.x << 16); v[1] = __uint_as_float(raw.x & 0xffff0000u); v[2] = __uint_as_float(raw.y << 16); v[3] = __uint_as_float(raw.y & 0xffff0000u);
            float ss = v[0] * v[0] + v[1] * v[1] + v[2] * v[2] + v[3] * v[3];
            ss = wave_sum(ss);
            const float rstd = rsqrtf(ss * (1.0f / 256.0f) + 1e-6f);
            const f32x4 g = *(const f32x4*)(p.kvn + lane * 4);
            const f32x4 o = v * rstd * g;
            float* od = ri.isS ? p.out + O_CKVS + ((size_t)(ri.b * 64 + ri.t)) * 256 : p.out + O_CKVP + (size_t)row * 256;
            *(f32x4*)(od + lane * 4) = o;
            *(u32x2*)(ckvall + (size_t)kr * 256 + lane * 4) = pk4(o);
        }
        {
            const int i = lane & 31;
            const float x1 = bf2f(kperaw[(size_t)row * 64 + i]), x2 = bf2f(kperaw[(size_t)row * 64 + 32 + i]);
            float c, s; rope_cs(ri.pos, 2 * i, c, s);
            const float o1 = x1 * c - x2 * s, o2 = x1 * s + x2 * c;
            float* od = ri.isS ? p.out + O_KPES + ((size_t)(ri.b * 64 + ri.t)) * 64 : p.out + O_KPEP + (size_t)row * 64;
            if (lane < 32) { od[i] = o1; od[32 + i] = o2; kpeall[(size_t)kr * 64 + i] = f2bf(o1); kpeall[(size_t)kr * 64 + 32 + i] = f2bf(o2); }
        }
    }
}

#define MFMA32(a, b, c) __builtin_amdgcn_mfma_f32_32x32x16_bf16((a), (b), (c), 0, 0, 0)
DI int pi32(int r) { return (r & 0x13) | ((r & 4) << 1) | ((r & 8) >> 1); }
DI int crow(int reg, int hh) { return (reg & 3) + 8 * (reg >> 2) + 4 * hh; }
DI bf16x8 pack8(const float (&v)[8]) {
    u32x4 o; o.x = pk2(v[0], v[1]); o.y = pk2(v[2], v[3]); o.z = pk2(v[4], v[5]); o.w = pk2(v[6], v[7]);
    return __builtin_bit_cast(bf16x8, o);
}
DI f32x16 zero16() { f32x16 z; for (int i = 0; i < 16; ++i) z[i] = 0.f; return z; }

DI void phase2_r1(const Params& p) {
    int tid = threadIdx.x; asm volatile("" : "+v"(tid));
    const int lane = tid & 63, w = __builtin_amdgcn_readfirstlane(tid >> 6), l31 = lane & 31, hh = lane >> 5;
    const bf16_t* rkt = (const bf16_t*)(p.ws + OFF_RKT);
    const bf16_t* rvt = (const bf16_t*)(p.ws + OFF_RVT);
    bf16_t* kvst = (bf16_t*)p.out;
    bf16_t* ss = (bf16_t*)(p.out + O_YS);
    for (int u = blockIdx.x; u < 1056; u += gridDim.x) {
        const bf16_t *ka, *va; size_t ts;
        ts = 64;
        if (u < 1024) { ka = rkt + (size_t)u * 8192; va = rvt + (size_t)u * 16384; }
        else { const int s = u - 1024; ka = rkt + RKT_S + (size_t)s * 8192; va = rvt + RVT_S + (size_t)s * 16384; }
        f32x16 acc[4];
#pragma unroll
        for (int i = 0; i < 4; ++i) acc[i] = zero16();
#define R1_LOAD(A_, B_, ks) do { A_ = *(const bf16x8*)(va + (size_t)(32 * w + l31) * ts + (ks) * 16 + hh * 8); \
            _Pragma("unroll") for (int dkt = 0; dkt < 4; ++dkt) B_[dkt] = *(const bf16x8*)(ka + (size_t)(dkt * 32 + l31) * ts + (ks) * 16 + hh * 8); } while (0)
#define R1_MMA(A_, B_) do { _Pragma("unroll") for (int dkt = 0; dkt < 4; ++dkt) acc[dkt] = MFMA32(B_[dkt], A_, acc[dkt]); } while (0)
        bf16x8 a0, a1, b0[4], b1[4];
        R1_LOAD(a0, b0, 0);
        __builtin_amdgcn_sched_barrier(0);
        R1_LOAD(a1, b1, 1); R1_MMA(a0, b0);
        __builtin_amdgcn_sched_barrier(0);
        R1_LOAD(a0, b0, 2); R1_MMA(a1, b1);
        __builtin_amdgcn_sched_barrier(0);
        R1_LOAD(a1, b1, 3); R1_MMA(a0, b0);
        __builtin_amdgcn_sched_barrier(0);
        R1_MMA(a1, b1);
        if (u < 1024) {
            bf16_t* o = kvst + (size_t)u * 32768;
#pragma unroll
            for (int dkt = 0; dkt < 4; ++dkt)
#pragma unroll
                for (int g = 0; g < 4; ++g) {
                    f32x4 v; v[0] = acc[dkt][4 * g]; v[1] = acc[dkt][4 * g + 1]; v[2] = acc[dkt][4 * g + 2]; v[3] = acc[dkt][4 * g + 3];
                    *(u32x2*)(o + (32 * w + l31) * 128 + dkt * 32 + 8 * g + 4 * hh) = pk4(v);
                }
        } else {
            const int s = u - 1024, h = s & 3;
            const float G = fexp2(64.0f * lg2gamma(h));
            const float* sin_ = p.st + (size_t)s * 32768;
            float* so = p.out + O_STS + (size_t)s * 32768;
            bf16_t* o = ss + (size_t)s * 32768;
#pragma unroll
            for (int dkt = 0; dkt < 4; ++dkt) {
                float sv[16];
#pragma unroll
                for (int reg = 0; reg < 16; ++reg) sv[reg] = sin_[(dkt * 32 + crow(reg, hh)) * 256 + 32 * w + l31];
#pragma unroll
                for (int reg = 0; reg < 16; ++reg) so[(dkt * 32 + crow(reg, hh)) * 256 + 32 * w + l31] = G * sv[reg] + acc[dkt][reg];
#pragma unroll
                for (int g = 0; g < 4; ++g) {
                    f32x4 v; v[0] = sv[4 * g]; v[1] = sv[4 * g + 1]; v[2] = sv[4 * g + 2]; v[3] = sv[4 * g + 3];
                    *(u32x2*)(o + (32 * w + l31) * 128 + dkt * 32 + 8 * g + 4 * hh) = pk4(v);
                }
            }
        }
    }
}
DI void phase3_scan(const Params& p) {
    const int gtid = blockIdx.x * NTHREADS + threadIdx.x, nth = gridDim.x * NTHREADS;
    bf16_t* kvst = (bf16_t*)p.out;
    for (int pidx = gtid; pidx < 8 * 16384; pidx += nth) {
        const int bh = pidx >> 14, e = (pidx & 16383) * 2, h = bh & 3;
        const float G = fexp2(64.0f * lg2gamma(h));
        float s0 = 0.f, s1 = 0.f;
        unsigned* ptr = (unsigned*)(kvst + (size_t)bh * 128 * 32768 + e);
#pragma unroll 1
        for (int c0 = 0; c0 < 128; c0 += 32) {
            unsigned v[32];
#pragma unroll
            for (int i = 0; i < 32; ++i) v[i] = ptr[(size_t)(c0 + i) * 16384];
#pragma unroll
            for (int i = 0; i < 32; ++i) {
                ptr[(size_t)(c0 + i) * 16384] = pk2(s0, s1);
                s0 = G * s0 + __uint_as_float(v[i] << 16); s1 = G * s1 + __uint_as_float(v[i] & 0xffff0000u);
            }
        }
        const int dv = e >> 7, dk = e & 127;
        float* so = p.out + O_STP + (size_t)bh * 32768;
        so[dk * 256 + dv] = s0; so[(dk + 1) * 256 + dv] = s1;
    }
}
DI f32x4 unpk4_(u32x2 b) { f32x4 r; r[0] = __uint_as_float(b.x << 16); r[1] = __uint_as_float(b.x & 0xffff0000u); r[2] = __uint_as_float(b.y << 16); r[3] = __uint_as_float(b.y & 0xffff0000u); return r; }
DI void r3_sample_unit(const Params& p, int s, LAS unsigned char* lds) {
    int tid = threadIdx.x; asm volatile("" : "+v"(tid));
    const int lane = tid & 63, w = __builtin_amdgcn_readfirstlane(tid >> 6), l31 = lane & 31, hh = lane >> 5;
    const bf16_t* rq = (const bf16_t*)(p.ws + OFF_RQ);
    const bf16_t* rk = (const bf16_t*)(p.ws + OFF_RK);
    const bf16_t* srg = (const bf16_t*)(p.ws + OFF_SRG);
    bf16_t* retin = (bf16_t*)(p.ws + OFF_RETIN);
    const int qh = w & 1, dq = w >> 1, h = s & 3, rowbase = TP + (s >> 2) * 64;
    const bf16_t* stp = (const bf16_t*)(p.out + O_YS) + (size_t)s * 32768 + (size_t)dq * 64 * 128;
    const bf16_t* vt = (const bf16_t*)(p.ws + OFF_RVT) + RVT_S + (size_t)s * 16384 + (size_t)dq * 64 * 64;
    const int l = qh * 32 + l31;
    const float lg = lg2gamma(h);
    const char* qbase = (const char*)(rq + (size_t)(rowbase + qh * 32) * 512 + h * 128);
    const unsigned qoff = (unsigned)(l31 * 512 + hh * 8) * 2u;
    f32x16 acc[2]; acc[0] = zero16(); acc[1] = zero16();
    const unsigned soff = (unsigned)(l31 * 128 + hh * 8) * 2u;
#pragma unroll
    for (int ks = 0; ks < 8; ++ks) {
        const bf16x8 bq = *(const bf16x8*)(qbase + qoff + ks * 32);
#pragma unroll
        for (int t = 0; t < 2; ++t) { const bf16x8 a = *(const bf16x8*)((const char*)stp + soff + t * 8192 + ks * 32); acc[t] = MFMA32(a, bq, acc[t]); }
    }
    const float qd = fexp2((float)(l + 1) * lg);
    acc[0] *= qd; acc[1] *= qd;
    const unsigned voff = (unsigned)(l31 * 64 + hh * 8) * 2u;
    const unsigned koff = (unsigned)(pi32(l31) * 512 + hh * 8) * 2u;
    for (int kt = 0; kt <= qh; ++kt) {
        f32x16 sc = zero16();
        const char* kbase = (const char*)(rk + (size_t)(rowbase + kt * 32) * 512 + h * 128);
#pragma unroll
        for (int ks = 0; ks < 8; ++ks) { const bf16x8 a = *(const bf16x8*)(kbase + koff + ks * 32); const bf16x8 bq = *(const bf16x8*)(qbase + qoff + ks * 32); sc = MFMA32(a, bq, sc); }
#pragma unroll
        for (int st = 0; st < 2; ++st) {
            float v[8];
#pragma unroll
            for (int j = 0; j < 8; ++j) { const int reg = 8 * st + j, m = kt * 32 + pi32(crow(reg, hh)), d = l - m; v[j] = d >= 0 ? sc[reg] * fexp2((float)d * lg) : 0.f; }
            const bf16x8 P = pack8(v);
            const char* vbase = (const char*)vt + (kt * 2 + st) * 32;
#pragma unroll
            for (int t = 0; t < 2; ++t) { const bf16x8 a = *(const bf16x8*)(vbase + voff + t * 4096); acc[t] = MFMA32(a, P, acc[t]); }
        }
    }
    float sum = 0.f, sq = 0.f;
#pragma unroll
    for (int t = 0; t < 2; ++t)
#pragma unroll
        for (int r = 0; r < 16; ++r) { const float x = acc[t][r]; sum += x; sq += x * x; }
    sum = xhalf_sum(sum); sq = xhalf_sum(sq);
    LAS f32x2* part = (LAS f32x2*)lds;
    __syncthreads();
    if (hh == 0) part[w * 32 + l31] = (f32x2){sum, sq};
    __syncthreads();
    sum = 0.f; sq = 0.f;
#pragma unroll
    for (int j = 0; j < 4; ++j) { const f32x2 v = part[(qh + 2 * j) * 32 + l31]; sum += v.x; sq += v.y; }
    const float mean = sum * (1.0f / 256.0f);
    const float rstd = rsqrtf(fmaxf(sq * (1.0f / 256.0f) - mean * mean, 0.f) + 1e-6f);
    const size_t orow = (size_t)(rowbase + l) * 1024 + h * 256 + dq * 64;
#pragma unroll
    for (int t = 0; t < 2; ++t) {
        f32x4 gwv[4]; u32x2 gtv[4];
#pragma unroll
        for (int g = 0; g < 4; ++g) { const int dv0 = t * 32 + 8 * g + 4 * hh; gwv[g] = *(const f32x4*)(p.gn + h * 256 + dq * 64 + dv0); gtv[g] = *(const u32x2*)(srg + orow + dv0); }
#pragma unroll
        for (int g = 0; g < 4; ++g) {
            const int dv0 = t * 32 + 8 * g + 4 * hh;
            const f32x4 gt = unpk4_(gtv[g]);
            f32x4 o;
#pragma unroll
            for (int j = 0; j < 4; ++j) o[j] = (acc[t][4 * g + j] - mean) * rstd * gwv[g][j] * gt[j];
            *(u32x2*)(retin + orow + dv0) = pk4(o);
        }
    }
}
DI void phase4_r3s(const Params& p, LAS unsigned char* lds) {
    for (int s = blockIdx.x; s < 32; s += gridDim.x) r3_sample_unit(p, s, lds);
}
DI void phase4_r3(const Params& p) {
    int tid = threadIdx.x; asm volatile("" : "+v"(tid));
    const int lane = tid & 63, w = __builtin_amdgcn_readfirstlane(tid >> 6), l31 = lane & 31, hh = lane >> 5;
    const bf16_t* rq = (const bf16_t*)(p.ws + OFF_RQ);
    const bf16_t* rk = (const bf16_t*)(p.ws + OFF_RK);
    const bf16_t* rvt = (const bf16_t*)(p.ws + OFF_RVT);
    const bf16_t* srg = (const bf16_t*)(p.ws + OFF_SRG);
    bf16_t* retin = (bf16_t*)(p.ws + OFF_RETIN);
    const bf16_t* kvst = (const bf16_t*)p.out;
    const bf16_t* ss = (const bf16_t*)(p.out + O_YS);
    const int nold = ((const int*)(p.ws + OFF_CTR))[40];
    for (int u = blockIdx.x; u < 256 + nold; u += gridDim.x) {
        int h, qh, rowbase; const bf16_t *stp, *vt; size_t ts;
        if (u < 256) { const int bh = u >> 5, c = (u & 31) * 4 + (w >> 1); qh = w & 1; h = bh & 3; rowbase = (bh >> 2) * 8192 + c * 64;
            stp = kvst + (size_t)(bh * 128 + c) * 32768; vt = rvt + (size_t)(bh * 128 + c) * 16384; ts = 64; }
        else { const int s = u - 256; if (w >= 2) continue; qh = w; h = s & 3; rowbase = TP + (s >> 2) * 64;
            stp = ss + (size_t)s * 32768; vt = rvt + RVT_S + (size_t)s * 16384; ts = 64; }
        const int l = qh * 32 + l31;
        const float lg = lg2gamma(h);
        const char* qbase = (const char*)(rq + (size_t)(rowbase + qh * 32) * 512 + h * 128);
        const unsigned qoff = (unsigned)(l31 * 512 + hh * 8) * 2u;
        f32x16 acc[8];
#pragma unroll
        for (int i = 0; i < 8; ++i) acc[i] = zero16();
        const unsigned soff = (unsigned)(l31 * 128 + hh * 8) * 2u;
#pragma unroll
        for (int ks = 0; ks < 8; ++ks) {
            const bf16x8 bq = *(const bf16x8*)(qbase + qoff + ks * 32);
#pragma unroll
            for (int dvt = 0; dvt < 8; ++dvt) {
                const bf16x8 a = *(const bf16x8*)((const char*)stp + soff + dvt * 8192 + ks * 32);
                acc[dvt] = MFMA32(a, bq, acc[dvt]);
            }
        }
        const float qd = fexp2((float)(l + 1) * lg);
#pragma unroll
        for (int dvt = 0; dvt < 8; ++dvt) acc[dvt] *= qd;
        const unsigned voff = (unsigned)(l31 * (unsigned)ts + hh * 8) * 2u;
        const unsigned vstep = (unsigned)ts * 64u;
        const unsigned koff = (unsigned)(pi32(l31) * 512 + hh * 8) * 2u;
        for (int kt = 0; kt <= qh; ++kt) {
            f32x16 s = zero16();
            const char* kbase = (const char*)(rk + (size_t)(rowbase + kt * 32) * 512 + h * 128);
#pragma unroll
            for (int ks = 0; ks < 8; ++ks) { const bf16x8 a = *(const bf16x8*)(kbase + koff + ks * 32); const bf16x8 bq = *(const bf16x8*)(qbase + qoff + ks * 32); s = MFMA32(a, bq, s); }
#pragma unroll
            for (int st = 0; st < 2; ++st) {
                float v[8];
#pragma unroll
                for (int j = 0; j < 8; ++j) {
                    const int reg = 8 * st + j, m = kt * 32 + pi32(crow(reg, hh)), d = l - m;
                    v[j] = d >= 0 ? s[reg] * fexp2((float)d * lg) : 0.f;
                }
                const bf16x8 P = pack8(v);
                const char* vbase = (const char*)vt + (kt * 2 + st) * 32;
#pragma unroll
                for (int dvt = 0; dvt < 8; ++dvt) {
                    const bf16x8 a = *(const bf16x8*)(vbase + voff + dvt * vstep);
                    acc[dvt] = MFMA32(a, P, acc[dvt]);
                }
            }
        }
        float sum = 0.f, sq = 0.f;
#pragma unroll
        for (int dvt = 0; dvt < 8; ++dvt)
#pragma unroll
            for (int r = 0; r < 16; ++r) { const float x = acc[dvt][r]; sum += x; sq += x * x; }
        sum = xhalf_sum(sum); sq = xhalf_sum(sq);
        const float mean = sum * (1.0f / 256.0f);
        const float rstd = rsqrtf(fmaxf(sq * (1.0f / 256.0f) - mean * mean, 0.f) + 1e-6f);
        const size_t orow = (size_t)(rowbase + l) * 1024 + h * 256;
#pragma unroll
        for (int dvt = 0; dvt < 8; ++dvt) {
            f32x4 gwv[4]; u32x2 gtv[4];
#pragma unroll
            for (int g = 0; g < 4; ++g) { const int dv0 = dvt * 32 + 8 * g + 4 * hh; gwv[g] = *(const f32x4*)(p.gn + h * 256 + dv0); gtv[g] = *(const u32x2*)(srg + orow + dv0); }
#pragma unroll
            for (int g = 0; g < 4; ++g) {
                const int dv0 = dvt * 32 + 8 * g + 4 * hh;
                const f32x4 gw = gwv[g];
                const u32x2 gt = gtv[g];
                f32x4 o;
                o[0] = (acc[dvt][4 * g + 0] - mean) * rstd * gw[0] * __uint_as_float(gt.x << 16);
                o[1] = (acc[dvt][4 * g + 1] - mean) * rstd * gw[1] * __uint_as_float(gt.x & 0xffff0000u);
                o[2] = (acc[dvt][4 * g + 2] - mean) * rstd * gw[2] * __uint_as_float(gt.y << 16);
                o[3] = (acc[dvt][4 * g + 3] - mean) * rstd * gw[3] * __uint_as_float(gt.y & 0xffff0000u);
                *(u32x2*)(retin + orow + dv0) = pk4(o);
            }
        }
    }
}

DI void epi_q(const Params& p, const f32x4 (&acc)[2][2][4][2], int pm, int tc) {
    EPI_IDS;
    bf16_t* q = (bf16_t*)(p.ws + OFF_Q);
    const float QS = 0.07216878364870322f * 1.4426950408889634f;
    const int row0 = pm * 256 + wr * 64 + fr;
    if (tc < 4) {
#pragma unroll
        for (int ai = 0; ai < 2; ++ai)
#pragma unroll
            for (int m = 0; m < 4; ++m) {
                const int row = row0 + ai * 128 + m * 16;
#pragma unroll
                for (int bj = 0; bj < 2; ++bj)
#pragma unroll
                    for (int n = 0; n < 2; ++n) {
                        const int d = wc * 32 + n * 16 + fq * 4, head = 2 * tc + bj;
                        *(u32x2*)(q + (size_t)row * 1536 + head * 192 + d) = pk4(acc[ai][bj][m][n] * QS);
                    }
            }
    } else {
#pragma unroll
        for (int ai = 0; ai < 2; ++ai)
#pragma unroll
            for (int m = 0; m < 4; ++m) {
                const int row = row0 + ai * 128 + m * 16;
                const RowInfo ri = rinfo(row);
#pragma unroll
                for (int n = 0; n < 2; ++n) {
                    const int i0 = n * 16 + fq * 4, head = 4 * (tc - 4) + wc;
                    const f32x4 x1 = acc[ai][0][m][n], x2 = acc[ai][1][m][n];
                    f32x4 o1, o2;
#pragma unroll
                    for (int j = 0; j < 4; ++j) { float c, s; rope_cs(ri.pos, 2 * (i0 + j), c, s); o1[j] = (x1[j] * c - x2[j] * s) * QS; o2[j] = (x1[j] * s + x2[j] * c) * QS; }
                    *(u32x2*)(q + (size_t)row * 1536 + head * 192 + 128 + i0) = pk4(o1);
                    *(u32x2*)(q + (size_t)row * 1536 + head * 192 + 160 + i0) = pk4(o2);
                }
            }
    }
}
DI void epi_kv(const Params& p, const f32x4 (&acc)[2][2][4][2], int pm, int tc) {
    EPI_IDS;
    bf16_t* knp = (bf16_t*)p.out;
    bf16_t* kns = (bf16_t*)(p.ws + OFF_KNS);
    const int row0 = pm * 256 + wr * 64 + fr;
#pragma unroll
    for (int ai = 0; ai < 2; ++ai)
#pragma unroll
        for (int m = 0; m < 4; ++m) {
            const int row = row0 + ai * 128 + m * 16;
            int isS, b, t;
            if (row < TP) { isS = 0; b = row >> 13; t = row & 8191; } else { const int r = row - TP; isS = 1; b = r / 2112; t = r - b * 2112; }
#pragma unroll
            for (int bj = 0; bj < 2; ++bj) {
                const int head = 2 * tc + bj;
#pragma unroll
                for (int n = 0; n < 2; ++n) {
                    const int d = wc * 32 + n * 16 + fq * 4;
                    bf16_t* dst = isS ? kns + ((size_t)(b * 8 + head) * 2112 + t) * 128 + d : knp + ((size_t)(b * 8 + head) * 8192 + t) * 128 + d;
                    *(u32x2*)dst = pk4(acc[ai][bj][m][n]);
                }
            }
        }
}
DI void epi_vT(const Params& p, const f32x4 (&acc)[2][2][4][2], int pm, int tc) {
    EPI_IDS;
    bf16_t* vtp = (bf16_t*)p.out + SZ_KNP / 2;
    bf16_t* vts = (bf16_t*)(p.ws + OFF_VTS);
#pragma unroll
    for (int bj = 0; bj < 2; ++bj)
#pragma unroll
        for (int n = 0; n < 2; ++n) {
            const int tok0 = pm * 256 + bj * 128 + wc * 32 + n * 16 + fq * 4;
#pragma unroll
            for (int ai = 0; ai < 2; ++ai) {
                const int head = 2 * (tc - 4) + ai;
                bf16_t* dst;
                if (tok0 < TP) { const int b = tok0 >> 13, t = tok0 & 8191; dst = vtp + ((size_t)(b * 8 + head) * 128 + (t >> 6)) * 8192 + (t & 63); }
                else { const int r = tok0 - TP, b = r / 2112, t = r - b * 2112; dst = vts + ((size_t)(b * 8 + head) * 33 + (t >> 6)) * 8192 + (t & 63); }
#pragma unroll
                for (int m = 0; m < 4; ++m) *(u32x2*)(dst + (wr * 64 + m * 16 + fr) * 64) = pk4(acc[ai][bj][m][n]);
            }
        }
}
struct SchedTiles {
    const bf16_t* A; const bf16_t* Bt; int lda, ldb, nM, nN, pn0, boff;
    DI bool next(int i, GUnit& u) const {
        int pm, pn; if (!tile_order((int)((blockIdx.x + boff) % gridDim.x) + i * gridDim.x, nM, nN, pm, pn)) return false;
        u.pm = pm; u.pn = pn + pn0; u.a = A + (size_t)pm * 256 * lda; u.b = Bt + (size_t)(pn + pn0) * 256 * ldb; return true;
    }
};
struct SchedKV {
    const bf16_t* X; const bf16_t* W;
    DI bool next(int i, GUnit& u) const {
        int pm, pn; if (!tile_order(blockIdx.x + i * gridDim.x, 130, 8, pm, pn)) return false;
        u.pm = pm; u.pn = pn;
        if (pn < 4) { u.a = X + (size_t)pm * 256 * 256; u.b = W + (size_t)pn * 256 * 256; }
        else { u.a = W + (size_t)pn * 256 * 256; u.b = X + (size_t)pm * 256 * 256; }
        return true;
    }
};
struct EpiKV {
    Params p;
    DI void operator()(const f32x4 (&acc)[2][2][4][2], const GUnit& u) const { if (u.pn < 4) epi_kv(p, acc, u.pm, u.pn); else epi_vT(p, acc, u.pm, u.pn); }
};
struct EpiQ {
    Params p;
    DI void operator()(const f32x4 (&acc)[2][2][4][2], const GUnit& u) const { epi_q(p, acc, u.pm, u.pn); }
};
DI void phase5_gemms(const Params& p, LAS unsigned char* shm) {
    {
        const SchedKV S{(const bf16_t*)(p.ws + OFF_CKVALL), (const bf16_t*)(p.ws + OFF_WUKV)};
        const EpiKV E{p};
        gemm_stream(shm, 256, false, 256, 4, S, E);
    }
    {
        const SchedTiles S{(const bf16_t*)(p.ws + OFF_CQ), (const bf16_t*)(p.ws + OFF_WUQ), 512, 512, 66, 6, 0, 140};
        const EpiQ E{p};
        gemm_stream(shm, 512, false, 512, 8, S, E);
    }
}

DI void phase6_attn(const Params& p, LAS unsigned char* lds, int cidx = 0) {
    int tid = threadIdx.x; asm volatile("" : "+v"(tid));
    const int lane = tid & 63, w = __builtin_amdgcn_readfirstlane(tid >> 6), l31 = lane & 31, hh = lane >> 5;
    unsigned* ctr = (unsigned*)(p.ws + OFF_CTR) + cidx;
    const bool dostore = ((const unsigned*)(p.ws + OFF_CTR))[32 + cidx] == 0u;
    bf16_t* q = (bf16_t*)(p.ws + OFF_Q);
    const bf16_t* knp = (const bf16_t*)p.out; const bf16_t* vtp = knp + SZ_KNP / 2;
    const bf16_t* kns = (const bf16_t*)(p.ws + OFF_KNS); const bf16_t* vts = (const bf16_t*)(p.ws + OFF_VTS);
    const bf16_t* kpeall = (const bf16_t*)(p.ws + OFF_KPEALL);
    constexpr int TBUF = 40960, KPO = 16384, VO = 24576, UOFF = 3 * TBUF;
    for (;;) {
        if (tid == 0) *(LAS unsigned*)(lds + UOFF) = atomicAdd(ctr, 1u);
        __syncthreads();
        const int u = (int)*(LAS unsigned*)(lds + UOFF);
        __syncthreads();
        if (u >= 576) break;
        const int uu = u < 368 ? u : (u < 432 ? 512 + (u - 368) : u - 64);
        int h, rowq0, nkt, limit; bool active; const bf16_t *kn, *kpe, *vt;
        if (uu < 512) { const int qb = 31 - (uu >> 4), bh = uu & 15, b = bh >> 3; h = bh & 7; rowq0 = b * 8192 + qb * 256; nkt = 4 * qb + 4; limit = 4 * qb + (w >> 1); active = true;
            kn = knp + (size_t)bh * 8192 * 128; kpe = kpeall + (size_t)b * 8192 * 64; vt = vtp + (size_t)bh * 128 * 8192; }
        else { const int su = uu - 512, b = su >> 3; h = su & 7; rowq0 = TP + b * 64; nkt = 33; limit = 32; active = w < 2;
            kn = kns + (size_t)su * 2112 * 128; kpe = kpeall + (size_t)(TP + b * 2112) * 64; vt = vts + (size_t)su * 33 * 8192; }
        bf16x8 Bq[12];
        bf16_t* qrow = q + (size_t)(rowq0 + 32 * w + l31) * 1536 + h * 192;
        if (active) {
#pragma unroll
            for (int ks = 0; ks < 12; ++ks) Bq[ks] = *(const bf16x8*)(qrow + ks * 16 + hh * 8);
        } else {
#pragma unroll
            for (int ks = 0; ks < 12; ++ks) Bq[ks] = (bf16x8){0, 0, 0, 0, 0, 0, 0, 0};
        }
        f32x16 o[4];
#pragma unroll
        for (int i = 0; i < 4; ++i) o[i] = zero16();
        float mrun = -INFINITY, lsum = 0.f;
        unsigned gk[2], gp, gv[2];
#pragma unroll
        for (int i = 0; i < 2; ++i) {
            const int rowk = 4 * (2 * w + i) + (lane >> 4), sl = lane & 15;
            gk[i] = (unsigned)(rowk * 128 + ((sl ^ (rowk & 15)) * 8));
            const int rowv = 8 * (2 * w + i) + (lane >> 3), sv = lane & 7;
            gv[i] = (unsigned)(rowv * 64 + ((sv ^ ((rowv >> 1) & 7)) * 8));
        }
        { const int rowp = 8 * w + (lane >> 3), sp = lane & 7; gp = (unsigned)(rowp * 64 + ((sp ^ ((rowp >> 1) & 7)) * 8)); }
#define ATT_GLDS(boff, kt) do { \
            __builtin_amdgcn_global_load_lds((const unsigned*)(kn + (size_t)(kt) * 8192 + gk[0]), (LAS unsigned*)(lds + (boff) + (2 * w) * 1024), 16, 0, 0); \
            __builtin_amdgcn_global_load_lds((const unsigned*)(kn + (size_t)(kt) * 8192 + gk[1]), (LAS unsigned*)(lds + (boff) + (2 * w + 1) * 1024), 16, 0, 0); \
            __builtin_amdgcn_global_load_lds((const unsigned*)(kpe + (size_t)(kt) * 4096 + gp), (LAS unsigned*)(lds + (boff) + KPO + w * 1024), 16, 0, 0); \
            __builtin_amdgcn_global_load_lds((const unsigned*)(vt + (size_t)(kt) * 8192 + gv[0]), (LAS unsigned*)(lds + (boff) + VO + (2 * w) * 1024), 16, 0, 0); \
            __builtin_amdgcn_global_load_lds((const unsigned*)(vt + (size_t)(kt) * 8192 + gv[1]), (LAS unsigned*)(lds + (boff) + VO + (2 * w + 1) * 1024), 16, 0, 0); } while (0)
        const int krow = pi32(l31);
        unsigned ka[12], va[4];
#pragma unroll
        for (int ks = 0; ks < 8; ++ks) ka[ks] = (unsigned)(krow * 256 + (((ks * 2 + hh) ^ (krow & 15)) * 16));
#pragma unroll
        for (int ks = 8; ks < 12; ++ks) ka[ks] = (unsigned)(KPO + krow * 128 + ((((ks - 8) * 2 + hh) ^ ((krow >> 1) & 7)) * 16));
#pragma unroll
        for (int kk = 0; kk < 4; ++kk) va[kk] = (unsigned)(VO + l31 * 128 + (((kk * 2 + hh) ^ ((l31 >> 1) & 7)) * 16));
        ATT_GLDS(0, 0);
        if (nkt > 1) { ATT_GLDS(TBUF, 1); asm volatile("s_waitcnt vmcnt(5)" ::: "memory"); }
        else asm volatile("s_waitcnt vmcnt(0)" ::: "memory");
        __syncthreads();
        int boff = 0, bnn = 2 * TBUF;
        for (int kt = 0; kt < nkt; ++kt) {
            const bool more = kt + 2 < nkt;
            if (more) ATT_GLDS(bnn, kt + 2);
            if (active && kt <= limit) {
                const LAS unsigned char* tb = lds + boff;
#define KFR(sub, ks) (*(const LAS bf16x8*)(tb + ka[ks] + (sub) * 32 * ((ks) < 8 ? 256 : 128)))
#define VFR(f) (*(const LAS bf16x8*)(tb + va[(f) & 3] + ((f) >> 2) * 32 * 128))
#define SBAR __builtin_amdgcn_sched_barrier(0)
                bf16x8 fa[4], fb[4];
                f32x16 s[2]; s[0] = zero16(); s[1] = zero16();
#pragma unroll
                for (int i = 0; i < 4; ++i) fa[i] = KFR(0, i);
                SBAR;
#pragma unroll
                for (int i = 0; i < 4; ++i) { fb[i] = KFR(0, 4 + i); s[0] = MFMA32(fa[i], Bq[i], s[0]); }
                SBAR;
#pragma unroll
                for (int i = 0; i < 4; ++i) { fa[i] = KFR(0, 8 + i); s[0] = MFMA32(fb[i], Bq[4 + i], s[0]); }
                SBAR;
#pragma unroll
                for (int i = 0; i < 4; ++i) { fb[i] = KFR(1, i); s[0] = MFMA32(fa[i], Bq[8 + i], s[0]); }
                SBAR;
#pragma unroll
                for (int i = 0; i < 4; ++i) { fa[i] = KFR(1, 4 + i); s[1] = MFMA32(fb[i], Bq[i], s[1]); }
                SBAR;
#pragma unroll
                for (int i = 0; i < 4; ++i) { fb[i] = KFR(1, 8 + i); s[1] = MFMA32(fa[i], Bq[4 + i], s[1]); }
                SBAR;
#pragma unroll
                for (int i = 0; i < 4; ++i) { fa[i] = VFR(i); s[1] = MFMA32(fb[i], Bq[8 + i], s[1]); }
                SBAR;
                float mx = s[0][0];
#pragma unroll
                for (int r = 0; r < 16; ++r) { mx = fmaxf(mx, s[0][r]); mx = fmaxf(mx, s[1][r]); }
                mx = xhalf_max(mx);
                if (__builtin_amdgcn_ballot_w64(mx > mrun + 8.0f) != 0ull) {
                    const float mnew = mx > mrun + 8.0f ? mx : mrun;
                    const float alpha = fexp2(mrun - mnew);
                    mrun = mnew;
                    lsum *= alpha;
#pragma unroll
                    for (int dvt = 0; dvt < 4; ++dvt) o[dvt] *= alpha;
                }
                const float mnew = mrun;
                float ps = 0.f;
                bf16x8 P[4];
#pragma unroll
                for (int i = 0; i < 4; ++i) fb[i] = VFR(4 + i);
#pragma unroll
                for (int sub = 0; sub < 2; ++sub)
#pragma unroll
                    for (int st = 0; st < 2; ++st) {
                        float v[8];
#pragma unroll
                        for (int j = 0; j < 8; ++j) { v[j] = fexp2(s[sub][8 * st + j] - mnew); ps += v[j]; }
                        P[sub * 2 + st] = pack8(v);
                    }
                lsum += ps;
                SBAR;
#pragma unroll
                for (int i = 0; i < 4; ++i) o[0] = MFMA32(fa[i], P[i], o[0]);
                SBAR;
#pragma unroll
                for (int i = 0; i < 4; ++i) { fa[i] = VFR(8 + i); o[1] = MFMA32(fb[i], P[i], o[1]); }
                SBAR;
#pragma unroll
                for (int i = 0; i < 4; ++i) { fb[i] = VFR(12 + i); o[2] = MFMA32(fa[i], P[i], o[2]); }
                SBAR;
#pragma unroll
                for (int i = 0; i < 4; ++i) o[3] = MFMA32(fb[i], P[i], o[3]);
            }
            if (more) asm volatile("s_waitcnt vmcnt(5)" ::: "memory"); else asm volatile("s_waitcnt vmcnt(0)" ::: "memory");
            __syncthreads();
            { const int nb = boff + TBUF >= 3 * TBUF ? 0 : boff + TBUF; bnn = boff; boff = nb; }
        }
        if (active && dostore) {
            const float ltot = xhalf_sum(lsum);
            const float inv = 1.0f / ltot;
#pragma unroll
            for (int dvt = 0; dvt < 4; ++dvt)
#pragma unroll
                for (int g4 = 0; g4 < 4; ++g4) {
                    f32x4 v; v[0] = o[dvt][4 * g4] * inv; v[1] = o[dvt][4 * g4 + 1] * inv; v[2] = o[dvt][4 * g4 + 2] * inv; v[3] = o[dvt][4 * g4 + 3] * inv;
                    *(u32x2*)(qrow + dvt * 32 + 8 * g4 + 4 * hh) = pk4(v);
                }
        }
    }
}

template <int PASS>
DI void phase8_pass(const Params& p, LAS unsigned char* shm) {
    const bf16_t* sg = (const bf16_t*)(p.ws + (PASS == 0 ? OFF_SGA : OFF_SGB));
    bf16_t* merged = (bf16_t*)(p.ws + OFF_MERGED);
    for (int L = blockIdx.x;; L += gridDim.x) {
        int pm, pn; if (!tile_order(L, 64, 4, pm, pn)) break;
        f32x4 acc[2][2][4][2]; ZERO_ACC(acc);
        if (PASS == 0) gemm_kloop(acc, (const bf16_t*)(p.ws + OFF_RETIN), 1024, false, (const bf16_t*)(p.ws + OFF_WRO), 1024, 16, pm * 256, pn * 256, shm);
        else gemm_kloop(acc, (const bf16_t*)(p.ws + OFF_Q), 1536, true, (const bf16_t*)(p.ws + OFF_WMO), 1024, 16, pm * 256, pn * 256, shm);
        EPI_IDS;
        const int row0 = pm * 256 + wr * 64 + fr;
#pragma unroll
        for (int ai = 0; ai < 2; ++ai)
#pragma unroll
            for (int mp = 0; mp < 2; ++mp) {
                u32x2 gb[2][2][2], tb[2][2][2];
#pragma unroll
                for (int mm = 0; mm < 2; ++mm) {
                    const size_t rbase = (size_t)(row0 + ai * 128 + (mp * 2 + mm) * 16) * 1024 + pn * 256 + wc * 32 + fq * 4;
#pragma unroll
                    for (int bj = 0; bj < 2; ++bj)
#pragma unroll
                        for (int n = 0; n < 2; ++n) {
                            gb[mm][bj][n] = *(const u32x2*)(sg + rbase + bj * 128 + n * 16);
                            if (PASS == 1) tb[mm][bj][n] = *(const u32x2*)(merged + rbase + bj * 128 + n * 16);
                        }
                }
#pragma unroll
                for (int mm = 0; mm < 2; ++mm) {
                    const int m = mp * 2 + mm;
                    const size_t rbase = (size_t)(row0 + ai * 128 + m * 16) * 1024 + pn * 256 + wc * 32 + fq * 4;
#pragma unroll
                    for (int bj = 0; bj < 2; ++bj)
#pragma unroll
                        for (int n = 0; n < 2; ++n) {
                            const u32x2 b = gb[mm][bj][n];
                            f32x4 r; r[0] = __uint_as_float(b.x << 16); r[1] = __uint_as_float(b.x & 0xffff0000u); r[2] = __uint_as_float(b.y << 16); r[3] = __uint_as_float(b.y & 0xffff0000u);
                            f32x4 o = acc[ai][bj][m][n] * r;
                            if (PASS == 1) {
                                const u32x2 t = tb[mm][bj][n];
                                o[0] += __uint_as_float(t.x << 16); o[1] += __uint_as_float(t.x & 0xffff0000u); o[2] += __uint_as_float(t.y << 16); o[3] += __uint_as_float(t.y & 0xffff0000u);
                            }
                            *(u32x2*)(merged + rbase + bj * 128 + n * 16) = pk4(o);
                        }
                }
            }
    }
}
DI void phase8_merge(const Params& p, LAS unsigned char* shm) { phase8_pass<0>(p, shm); phase8_pass<1>(p, shm); }
DI float* hrow(const Params& p, int row) { return row < TP ? p.out + O_YP + (size_t)row * 1024 : p.out + O_YS + (size_t)(row - TP) * 1024; }
DI void phase9_out(const Params& p, LAS unsigned char* shm) {
    for (int L = blockIdx.x;; L += gridDim.x) {
        int pm, pn; if (!tile_order(L, 64, 4, pm, pn)) break;
        f32x4 acc[2][2][4][2]; ZERO_ACC(acc);
        gemm_kloop(acc, (const bf16_t*)(p.ws + OFF_MERGED), 1024, false, (const bf16_t*)(p.ws + OFF_WOUT), 1024, 16, pm * 256, pn * 256, shm);
        EPI_IDS;
        const int row0 = pm * 256 + wr * 64 + fr;
        const int cb = pn * 256 + wc * 32 + fq * 4;
        f32x4 gv[2][2];
#pragma unroll
        for (int bj = 0; bj < 2; ++bj)
#pragma unroll
            for (int n = 0; n < 2; ++n) gv[bj][n] = *(const f32x4*)(p.nffn + cb + bj * 128 + n * 16);
#pragma unroll
        for (int ai = 0; ai < 2; ++ai)
#pragma unroll
            for (int mp = 0; mp < 2; ++mp) {
                f32x4 xv[2][2][2];
#pragma unroll
                for (int mm = 0; mm < 2; ++mm) {
                    const int row = row0 + ai * 128 + (mp * 2 + mm) * 16;
                    const float* xr = row < TP ? p.x_p + (size_t)row * 1024 : p.x_s + (size_t)(row - TP) * 1024;
#pragma unroll
                    for (int bj = 0; bj < 2; ++bj)
#pragma unroll
                        for (int n = 0; n < 2; ++n) xv[mm][bj][n] = *(const f32x4*)(xr + cb + bj * 128 + n * 16);
                }
#pragma unroll
                for (int mm = 0; mm < 2; ++mm) {
                    const int m = mp * 2 + mm, row = row0 + ai * 128 + m * 16;
                    float* hr = hrow(p, row);
                    bf16_t* hb = (bf16_t*)(p.ws + OFF_HN) + (size_t)row * 1024;
                    float ss = 0.f;
#pragma unroll
                    for (int bj = 0; bj < 2; ++bj)
#pragma unroll
                        for (int n = 0; n < 2; ++n) {
                            const int c = cb + bj * 128 + n * 16;
                            const f32x4 hv = xv[mm][bj][n] + acc[ai][bj][m][n];
                            *(f32x4*)(hr + c) = hv;
                            *(u32x2*)(hb + c) = pk4(hv * gv[bj][n]);
                            ss += hv[0] * hv[0] + hv[1] * hv[1] + hv[2] * hv[2] + hv[3] * hv[3];
                        }
                    ss += __shfl_xor(ss, 16); ss += __shfl_xor(ss, 32);
                    if (fq == 0) atomicAdd((float*)(p.ws + OFF_ROWSS) + row, ss);
                }
            }
    }
}
DI void phase10_hn(const Params& p) {
    const int gtid = blockIdx.x * NTHREADS + threadIdx.x, nth = gridDim.x * NTHREADS;
    const int gw = gtid >> 6, nw = nth >> 6, lane = threadIdx.x & 63;
    bf16_t* hn = (bf16_t*)(p.ws + OFF_HN);
    for (int row = gw; row < TALL; row += 2 * nw) {
        const int row2 = row + nw;
        if (row2 < TALL) rmsnorm_row2_1024(hrow(p, row), hrow(p, row2), p.nffn, hn + (size_t)row * 1024, hn + (size_t)row2 * 1024, lane);
        else rmsnorm_row_1024(hrow(p, row), p.nffn, hn + (size_t)row * 1024, lane);
    }
}
struct EpiGU {
    Params p;
    DI void operator()(const f32x4 (&acc)[2][2][4][2], const GUnit& u) const {
        EPI_IDS;
        bf16_t* act = (bf16_t*)(p.ws + OFF_ACT);
        const int row0 = u.pm * 256 + wr * 64 + fr;
        float rss[2][4];
#pragma unroll
        for (int ai = 0; ai < 2; ++ai)
#pragma unroll
            for (int m = 0; m < 4; ++m) rss[ai][m] = ((const float*)(p.ws + OFF_ROWSS))[row0 + ai * 128 + m * 16];
#pragma unroll
        for (int ai = 0; ai < 2; ++ai)
#pragma unroll
            for (int m = 0; m < 4; ++m) {
                const float rstd = rsqrtf(rss[ai][m] * (1.0f / 1024.0f) + 1e-6f);
#pragma unroll
                for (int n = 0; n < 2; ++n) {
                    const f32x4 g = acc[ai][0][m][n] * rstd, uu = acc[ai][1][m][n] * rstd;
                    f32x4 o;
#pragma unroll
                    for (int j = 0; j < 4; ++j) o[j] = siluf_(g[j]) * uu[j];
                    *(u32x2*)(act + (size_t)(row0 + ai * 128 + m * 16) * 2816 + u.pn * 128 + wc * 32 + n * 16 + fq * 4) = pk4(o);
                }
            }
    }
};
DI void phase11_gu(const Params& p, LAS unsigned char* shm) {
    const SchedTiles S{(const bf16_t*)(p.ws + OFF_HN), (const bf16_t*)(p.ws + OFF_WGU), 1024, 1024, 66, 22, 0, 0};
    const EpiGU E{p};
    gemm_stream(shm, 1024, false, 1024, 16, S, E);
}
DI unsigned xb_ld(unsigned* p);
DI unsigned xb_add(unsigned* p, unsigned v);
struct EpiDown {
    Params p; bool fused; LAS unsigned char* shm;
    DI void operator()(f32x4 (&acc)[2][2][4][2], const GUnit& u) const {
        EPI_IDS;
        const int tid = wid * 64 + lane;
        const int row0 = u.pm * 256 + wr * 64 + fr;
        const int cb = u.pn * 256 + wc * 32 + fq * 4;
        float ssr[2][4];
#pragma unroll
        for (int ai = 0; ai < 2; ++ai)
#pragma unroll
            for (int mp = 0; mp < 2; ++mp) {
                f32x4 hv[2][2][2];
#pragma unroll
                for (int mm = 0; mm < 2; ++mm) {
                    const float* hr = hrow(p, row0 + ai * 128 + (mp * 2 + mm) * 16);
#pragma unroll
                    for (int bj = 0; bj < 2; ++bj)
#pragma unroll
                        for (int n = 0; n < 2; ++n) hv[mm][bj][n] = *(const f32x4*)(hr + cb + bj * 128 + n * 16);
                }
#pragma unroll
                for (int mm = 0; mm < 2; ++mm) {
                    const int m = mp * 2 + mm;
                    float ss = 0.f;
#pragma unroll
                    for (int bj = 0; bj < 2; ++bj)
#pragma unroll
                        for (int n = 0; n < 2; ++n) {
                            const f32x4 v = hv[mm][bj][n] + acc[ai][bj][m][n];
                            acc[ai][bj][m][n] = v;
                            ss += v[0] * v[0] + v[1] * v[1] + v[2] * v[2] + v[3] * v[3];
                        }
                    ss += __shfl_xor(ss, 16); ss += __shfl_xor(ss, 32);
                    ssr[ai][m] = ss;
                }
            }
        if (!fused) {
#pragma unroll
            for (int ai = 0; ai < 2; ++ai)
#pragma unroll
                for (int m = 0; m < 4; ++m) {
                    float* hr = hrow(p, row0 + ai * 128 + m * 16);
#pragma unroll
                    for (int bj = 0; bj < 2; ++bj)
#pragma unroll
                        for (int n = 0; n < 2; ++n) *(f32x4*)(hr + cb + bj * 128 + n * 16) = acc[ai][bj][m][n];
                }
            return;
        }
        LAS float* part = (LAS float*)shm;
        LAS float* rst = part + 1024;
        __syncthreads();
        if (fq == 0) {
#pragma unroll
            for (int ai = 0; ai < 2; ++ai)
#pragma unroll
                for (int m = 0; m < 4; ++m) part[wc * 256 + ai * 128 + wr * 64 + m * 16 + fr] = ssr[ai][m];
        }
        __syncthreads();
        float* xbuf = (float*)(p.ws + OFF_XBUF) + (size_t)u.pm * 1024;
        unsigned* cnt = (unsigned*)(p.ws + OFF_PCNT) + u.pm * 64;
        if (tid < 256) __hip_atomic_store(xbuf + u.pn * 256 + tid, part[tid] + part[256 + tid] + part[512 + tid] + part[768 + tid], __ATOMIC_RELAXED, __HIP_MEMORY_SCOPE_AGENT);
        __builtin_amdgcn_fence(__ATOMIC_RELEASE, "agent");
        asm volatile("s_waitcnt vmcnt(0)" ::: "memory");
        __syncthreads();
        if (tid == 0) {
            xb_add(cnt, 1u);
            unsigned sp = 0;
            while (xb_ld(cnt) < 4u) { __builtin_amdgcn_s_sleep(1); if (++sp > (1u << 22)) break; }
            __builtin_amdgcn_fence(__ATOMIC_ACQUIRE, "agent");
            asm volatile("s_waitcnt vmcnt(0)" ::: "memory");
        }
        __syncthreads();
        if (tid < 256) {
            float s = 0.f;
#pragma unroll
            for (int q = 0; q < 4; ++q) s += __hip_atomic_load(xbuf + q * 256 + tid, __ATOMIC_RELAXED, __HIP_MEMORY_SCOPE_AGENT);
            rst[tid] = rsqrtf(s * (1.0f / 1024.0f) + 1e-6f);
        }
        __syncthreads();
        f32x4 gv[2][2];
#pragma unroll
        for (int bj = 0; bj < 2; ++bj)
#pragma unroll
            for (int n = 0; n < 2; ++n) gv[bj][n] = *(const f32x4*)(p.nfin + cb + bj * 128 + n * 16);
#pragma unroll
        for (int ai = 0; ai < 2; ++ai)
#pragma unroll
            for (int m = 0; m < 4; ++m) {
                const float rs = rst[ai * 128 + wr * 64 + m * 16 + fr];
                float* yr = hrow(p, row0 + ai * 128 + m * 16);
#pragma unroll
                for (int bj = 0; bj < 2; ++bj)
#pragma unroll
                    for (int n = 0; n < 2; ++n) *(f32x4*)(yr + cb + bj * 128 + n * 16) = acc[ai][bj][m][n] * rs * gv[bj][n];
            }
    }
};
DI void phase12_down(const Params& p, LAS unsigned char* shm, bool fused) {
    const SchedTiles S{(const bf16_t*)(p.ws + OFF_ACT), (const bf16_t*)(p.ws + OFF_WDN), 2816, 2816, 64, 4, 0, 0};
    const EpiDown E{p, fused, shm};
    if (fused) gemm_stream<true>(shm, 2816, false, 2816, 44, S, E);
    else gemm_stream<false>(shm, 2816, false, 2816, 44, S, E);
}
DI void phase13_final(const Params& p, int rowstart) {
    const int gtid = blockIdx.x * NTHREADS + threadIdx.x, nth = gridDim.x * NTHREADS;
    const int gw = gtid >> 6, nw = nth >> 6, lane = threadIdx.x & 63;
    for (int row = rowstart + gw; row < TALL; row += nw) {
        float* x = hrow(p, row);
        f32x4 v[4]; float ss = 0.f;
#pragma unroll
        for (int i = 0; i < 4; ++i) { v[i] = *(const f32x4*)(x + i * 256 + lane * 4); ss += v[i][0] * v[i][0] + v[i][1] * v[i][1] + v[i][2] * v[i][2] + v[i][3] * v[i][3]; }
        ss = wave_sum(ss);
        const float rstd = rsqrtf(ss * (1.0f / 1024.0f) + 1e-6f);
#pragma unroll
        for (int i = 0; i < 4; ++i) { const f32x4 gg = *(const f32x4*)(p.nfin + i * 256 + lane * 4); *(f32x4*)(x + i * 256 + lane * 4) = v[i] * rstd * gg; }
    }
}

DI f32x4 thin_block(const bf16_t* __restrict__ A, int lda, bool a192, const bf16_t* __restrict__ Bt, int ldb, int K, int row0, int col0, LAS unsigned char* lds) {
    int tid = threadIdx.x; asm volatile("" : "+v"(tid));
    const int lane = tid & 63, w = __builtin_amdgcn_readfirstlane(tid >> 6), l31 = lane & 31, hh = lane >> 5;
    const int kw = K >> 3;
    const int kb = w * kw, ka = a192 ? w * 192 : kb;
    const bf16_t* ap = A + (size_t)(row0 + l31) * lda + ka + hh * 8;
    const bf16_t* bp = Bt + (size_t)(col0 + l31) * ldb + kb + hh * 8;
    f32x16 acc0 = zero16(), acc1 = zero16();
    for (int k = 0; k < kw; k += 64) {
        bf16x8 a[4], b0[4], b1[4];
#pragma unroll
        for (int i = 0; i < 4; ++i) {
            const int kk = k + 16 * i;
            const bool ok = kk < kw;
            a[i] = ok ? *(const bf16x8*)(ap + kk) : (bf16x8){0, 0, 0, 0, 0, 0, 0, 0};
            b0[i] = ok ? *(const bf16x8*)(bp + kk) : (bf16x8){0, 0, 0, 0, 0, 0, 0, 0};
            b1[i] = ok ? *(const bf16x8*)(bp + (size_t)32 * ldb + kk) : (bf16x8){0, 0, 0, 0, 0, 0, 0, 0};
        }
#pragma unroll
        for (int i = 0; i < 4; ++i) { acc0 = MFMA32(a[i], b0[i], acc0); acc1 = MFMA32(a[i], b1[i], acc1); }
    }
    __syncthreads();
    LAS float* part = (LAS float*)lds;
#pragma unroll
    for (int r = 0; r < 16; ++r) {
        const int row = crow(r, hh);
        part[(w * 32 + row) * 64 + l31] = acc0[r];
        part[(w * 32 + row) * 64 + 32 + l31] = acc1[r];
    }
    __syncthreads();
    f32x4 o = {0.f, 0.f, 0.f, 0.f};
#pragma unroll
    for (int ww = 0; ww < 8; ++ww) o += *(const LAS f32x4*)(part + (ww * 32 + (tid >> 4)) * 64 + (tid & 15) * 4);
    return o;
}
template <int WHICH>
DI void thin_phase(const Params& p, LAS unsigned char* lds) {
    const int ncb = WHICH == 7 ? 32 : 16;
    for (int t = blockIdx.x; t < 16 * ncb; t += gridDim.x) {
        const int rbk = t & 15, cbk = t >> 4;
        const int row0 = TP + rbk * 32, col0 = cbk * 64;
        int tid = threadIdx.x; asm volatile("" : "+v"(tid));
        const int row = row0 + (tid >> 4), c = col0 + (tid & 15) * 4;
        if (WHICH == 7) {
            const f32x4 acc = thin_block((const bf16_t*)(p.ws + OFF_XN), 1024, false, (const bf16_t*)(p.ws + OFF_WIN) + (size_t)4096 * 1024, 1024, 1024, row0, col0, lds);
            bf16_t* dst = (bf16_t*)(p.ws + (c < 1024 ? OFF_SGA : OFF_SGB)) + (size_t)row * 1024 + (c & 1023);
            f32x4 v; for (int j = 0; j < 4; ++j) v[j] = sigmoidf_(acc[j]);
            *(u32x2*)dst = pk4(v);
        } else if (WHICH == 8) {
            const f32x4 a1 = thin_block((const bf16_t*)(p.ws + OFF_RETIN), 1024, false, (const bf16_t*)(p.ws + OFF_WRO), 1024, 1024, row0, col0, lds);
            const f32x4 a2 = thin_block((const bf16_t*)(p.ws + OFF_Q), 1536, true, (const bf16_t*)(p.ws + OFF_WMO), 1024, 1024, row0, col0, lds);
            const size_t idx = (size_t)row * 1024 + c;
            const u32x2 ga = *(const u32x2*)((const bf16_t*)(p.ws + OFF_SGA) + idx), gb = *(const u32x2*)((const bf16_t*)(p.ws + OFF_SGB) + idx);
            f32x4 o;
            o[0] = __uint_as_float(ga.x << 16) * a1[0] + __uint_as_float(gb.x << 16) * a2[0];
            o[1] = __uint_as_float(ga.x & 0xffff0000u) * a1[1] + __uint_as_float(gb.x & 0xffff0000u) * a2[1];
            o[2] = __uint_as_float(ga.y << 16) * a1[2] + __uint_as_float(gb.y << 16) * a2[2];
            o[3] = __uint_as_float(ga.y & 0xffff0000u) * a1[3] + __uint_as_float(gb.y & 0xffff0000u) * a2[3];
            *(u32x2*)((bf16_t*)(p.ws + OFF_MERGED) + idx) = pk4(o);
        } else if (WHICH == 9) {
            const f32x4 acc = thin_block((const bf16_t*)(p.ws + OFF_MERGED), 1024, false, (const bf16_t*)(p.ws + OFF_WOUT), 1024, 1024, row0, col0, lds);
            const size_t o = (size_t)(row - TP) * 1024 + c;
            const f32x4 hv = *(const f32x4*)(p.x_s + o) + acc;
            *(f32x4*)(p.out + O_YS + o) = hv;
            *(u32x2*)((bf16_t*)(p.ws + OFF_HN) + (size_t)row * 1024 + c) = pk4(hv * *(const f32x4*)(p.nffn + c));
            float ss = hv[0] * hv[0] + hv[1] * hv[1] + hv[2] * hv[2] + hv[3] * hv[3];
            ss += __shfl_xor(ss, 1); ss += __shfl_xor(ss, 2); ss += __shfl_xor(ss, 4); ss += __shfl_xor(ss, 8);
            if ((tid & 15) == 0) atomicAdd((float*)(p.ws + OFF_ROWSS) + row, ss);
        } else {
            const f32x4 acc = thin_block((const bf16_t*)(p.ws + OFF_ACT), 2816, false, (const bf16_t*)(p.ws + OFF_WDN), 2816, 2816, row0, col0, lds);
            float* hp = p.out + O_YS + (size_t)(row - TP) * 1024 + c;
            *(f32x4*)hp = *(const f32x4*)hp + acc;
        }
    }
}

#define XB_TMO      128
#define XB_XCNT(j)  (256  + 64 * (j))
#define XB_XSUB(j)  (1280 + 64 * (j))
#define XB_XGEN(j)  (2304 + 64 * (j))
#define XB_TOP      3328
#define XB_TOPGEN   3392
#define XCD_BAR_WORDS 3456
#define XB_SPIN_CAP (1u << 18)
DI unsigned xb_ld(unsigned* p) { return __hip_atomic_load(p, __ATOMIC_RELAXED, __HIP_MEMORY_SCOPE_AGENT); }
DI unsigned xb_add(unsigned* p, unsigned v) { return __hip_atomic_fetch_add(p, v, __ATOMIC_RELAXED, __HIP_MEMORY_SCOPE_AGENT); }
DI unsigned xb_xcc_id() { return (unsigned)__builtin_amdgcn_s_getreg((3 << 11) | 20) & 0xFu; }
#define XB_SPIN(cond, bar) do { unsigned _sp = 0; while (cond) { __builtin_amdgcn_s_sleep(1); \
    if ((++_sp & 255u) == 0u) { if (xb_ld(&(bar)[XB_TMO])) break; if (_sp > XB_SPIN_CAP) { atomicAdd(&(bar)[XB_TMO], 1u); break; } } } } while (0)
struct XcdBarrier { unsigned* bar; unsigned x; volatile LAS unsigned* st; };
DI XcdBarrier xcd_barrier_post(unsigned* bar, volatile LAS unsigned* st) {
    XcdBarrier b; b.bar = bar; b.x = xb_xcc_id(); b.st = st;
    if (threadIdx.x == 0) (void)xb_add(&bar[XB_XCNT(b.x)], 1u);
    return b;
}
DI void xcd_barrier_complete(unsigned* bar, unsigned x, unsigned& nloc, unsigned& nx) {
    const unsigned G = gridDim.x * gridDim.y * gridDim.z;
    unsigned sum, cnt, mine, sp = 0u;
    for (;;) {
        sum = 0u; cnt = 0u; mine = 0u;
#pragma unroll
        for (unsigned j = 0; j < 16; ++j) { const unsigned c = xb_ld(&bar[XB_XCNT(j)]); sum += c; cnt += (c > 0u) ? 1u : 0u; mine = (j == x) ? c : mine; }
        if (sum == G) break;
        __builtin_amdgcn_s_sleep(1);
        if ((++sp & 255u) == 0u) { if (xb_ld(&bar[XB_TMO])) break; if (sp > XB_SPIN_CAP) { atomicAdd(&bar[XB_TMO], 1u); break; } }
    }
    nloc = mine > 0u ? mine : 1u; nx = cnt > 0u ? cnt : 1u;
}
DI void xcd_barrier(const XcdBarrier& b) {
    asm volatile("s_waitcnt vmcnt(0)" ::: "memory");
    __syncthreads();
    if (threadIdx.x == 0) {
        unsigned* bar = b.bar;
        __builtin_amdgcn_s_waitcnt(0);
        unsigned nloc = b.st[0], nx = b.st[1];
        if (nloc == 0u) { xcd_barrier_complete(bar, b.x, nloc, nx); b.st[0] = nloc; b.st[1] = nx; }
        const unsigned old = xb_add(&bar[XB_XSUB(b.x)], 1u);
        const unsigned gen = old / nloc;
        if (old + 1u == (gen + 1u) * nloc) {
            __builtin_amdgcn_fence(__ATOMIC_RELEASE, "agent");
            asm volatile("s_waitcnt vmcnt(0)" ::: "memory");
            const unsigned og = xb_add(&bar[XB_TOP], 1u);
            const unsigned tg = og / nx;
            if (og + 1u == (tg + 1u) * nx) xb_add(&bar[XB_TOPGEN], 1u);
            else XB_SPIN(xb_ld(&bar[XB_TOPGEN]) == tg, bar);
            __builtin_amdgcn_fence(__ATOMIC_ACQUIRE, "agent");
            xb_add(&bar[XB_XGEN(b.x)], 1u);
            asm volatile("s_waitcnt vmcnt(0)" ::: "memory");
        } else {
            XB_SPIN(xb_ld(&bar[XB_XGEN(b.x)]) == gen, bar);
            __builtin_amdgcn_fence(__ATOMIC_ACQUIRE, "agent");
            asm volatile("s_waitcnt vmcnt(0)" ::: "memory");
        }
    }
    __syncthreads();
}

__global__ void __launch_bounds__(NTHREADS) fwd_megakernel(Params p) {
    extern __shared__ __attribute__((aligned(16))) unsigned char smem[];
    cg::grid_group grid = cg::this_grid();
    LAS unsigned char* shm = (LAS unsigned char*)smem;
#ifndef PMASK
#define PMASK 0xffff
#endif
#define PH(k) if ((PMASK >> (k)) & 1)
    volatile LAS unsigned* xst = (volatile LAS unsigned*)(shm + 131072);
    if (threadIdx.x == 0) { xst[0] = 0u; xst[1] = 0u; }
    __syncthreads();
    const XcdBarrier xbar = xcd_barrier_post((unsigned*)(p.ws + OFF_BAR), xst);
    if (p.ws == nullptr) grid.sync();
#define GSYNC() xcd_barrier(xbar)
#ifdef TIMING_RUN
    unsigned long long* tsb = (unsigned long long*)(p.ws + OFF_CTR + 256);
    int tsi = 0;
#define STAMP() do { if (blockIdx.x == 0 && threadIdx.x == 0) tsb[tsi] = wall_clock64(); ++tsi; } while (0)
#else
#define STAMP() do {} while (0)
#endif
    STAMP();
    PH(0) phase0(p, shm);
#if PROBE_DOUBLE == 100
    phase0(p, shm);
#endif
    GSYNC(); STAMP();
    PH(1) phase1_gemm(p, shm);
#if PROBE_DOUBLE == 1
    phase1_gemm(p, shm);
#endif
    GSYNC(); STAMP();
    PH(2) { phase2_elem(p); phase2_r1(p); }
#if PROBE_DOUBLE == 2
    phase2_r1(p);
#endif
#if PROBE_DOUBLE == 200
    for (int i_ = 0; i_ < 10; ++i_) GSYNC();
#endif
#if PROBE_DOUBLE == 12
    phase10_hn(p); phase10_hn(p);
#endif
    GSYNC(); STAMP();
    PH(3) phase3_scan(p);
    GSYNC(); STAMP();
    PH(4) { phase4_r3s(p, shm); phase4_r3(p); }
#if PROBE_DOUBLE == 4
    phase4_r3(p);
#endif
    GSYNC(); STAMP();
    PH(5) phase5_gemms(p, shm);
#if PROBE_DOUBLE == 5
    phase5_gemms(p, shm);
#endif
    GSYNC(); STAMP();
#if PROBE_DOUBLE == 6
    phase6_attn(p, shm, 1);
#endif
    PH(6) phase6_attn(p, shm);
    GSYNC(); STAMP();
    PH(7) { phase7_gates(p, shm); thin_phase<7>(p, shm); }
    STAMP();
    PH(8) { phase8_merge(p, shm); thin_phase<8>(p, shm); }
#if PROBE_DOUBLE == 8
    phase8_merge(p, shm);
#endif
    GSYNC(); STAMP();
    PH(9) { phase9_out(p, shm); thin_phase<9>(p, shm); }
    GSYNC(); STAMP();
    PH(11) phase11_gu(p, shm);
#if PROBE_DOUBLE == 11
    phase11_gu(p, shm);
#endif
    GSYNC(); STAMP();
    const bool fusedfin = gridDim.x == 256;
    PH(12) { phase12_down(p, shm, fusedfin); thin_phase<12>(p, shm); }
    GSYNC(); STAMP();
    PH(13) phase13_final(p, fusedfin ? TP : 0);
#ifdef TIMING_RUN
    STAMP();
    if (blockIdx.x == 0 && threadIdx.x == 0) {
        const unsigned long long d = tsb[TIMING_RUN + 1] - tsb[TIMING_RUN];
        const unsigned long long t0 = wall_clock64();
        while (wall_clock64() - t0 < d) __builtin_amdgcn_s_sleep(8);
    }
#endif
}

extern "C" void kernel_launch(void* const* d_in, const int* in_sizes, int n_in, void* d_out, int out_size, void* d_ws, size_t ws_size,
                              hipStream_t stream) {
    constexpr size_t kDynLds = 131072 + 16;
    static int grid_blocks = 0;
    if (!grid_blocks) {
        int dev = 0, cus = 0, per_cu = 0;
        hipGetDevice(&dev);
        hipDeviceGetAttribute(&cus, hipDeviceAttributeMultiprocessorCount, dev);
        hipFuncSetAttribute((const void*)fwd_megakernel, hipFuncAttributeMaxDynamicSharedMemorySize, (int)kDynLds);
        hipOccupancyMaxActiveBlocksPerMultiprocessor(&per_cu, fwd_megakernel, NTHREADS, kDynLds);
        if (per_cu < 1) per_cu = 1;
        grid_blocks = cus;
    }
    Params p{};
    const float** pp = (const float**)&p;
    for (int i = 0; i < 19; ++i) pp[i] = (const float*)d_in[i];
    p.out = (float*)d_out; p.ws = (char*)d_ws;
    hipMemsetAsync((char*)d_ws + OFF_CTR, 0, 65536 + 16896 * 4, stream);
    void* args[] = {&p};
    hipError_t e = hipLaunchCooperativeKernel((void*)fwd_megakernel, dim3(grid_blocks), dim3(NTHREADS), args, kDynLds, stream);
    if (e != hipSuccess) fprintf(stderr, "cooperative launch failed: %s (grid %d)\n", hipGetErrorString(e), grid_blocks);
}
```
